# Optimizing an MI355X kernel written in HIP

```python
import jax, jax.numpy as jnp
from jax import lax
import numpy as np

D_MODEL = 1024
BATCH = 4
SEQ = 4096
DEPTH = 2
DEC_BATCH = 8
DEC_SEQ = 32
PAST_LEN = 2048

CHUNK = 64
HEAD_DIM = 64
A_HEADS = D_MODEL // HEAD_DIM
A_KV_HEADS = A_HEADS // 4
A_GROUP = A_HEADS // A_KV_HEADS
A_WINDOW = 128
A_PREV = A_WINDOW // CHUNK
B_HEADS = D_MODEL // HEAD_DIM
B_PREV = 8
B_REACH = B_PREV * CHUNK
REL_CLIP = 128
N_REL = 2 * REL_CLIP + 1
D_FF = 2816
CONV_W = 3
EPS = 1e-6
NEG_INF = -1e30
A_Q = A_HEADS * HEAD_DIM
A_KV = A_KV_HEADS * HEAD_DIM
B_W = B_HEADS * HEAD_DIM
N_IN = A_Q + 2 * A_KV + 3 * B_W + 2 * D_MODEL
SPLITS = (A_Q, A_Q + A_KV, A_Q + 2 * A_KV, A_Q + 2 * A_KV + B_W,
          A_Q + 2 * A_KV + 2 * B_W, A_Q + 2 * A_KV + 3 * B_W,
          A_Q + 2 * A_KV + 3 * B_W + D_MODEL)

kernel_name = 'hybrid_swa_sink_chunkband_convffn_step'


def rmsnorm(x, g):
    xf = x.astype(jnp.float32)
    y = xf * lax.rsqrt(jnp.mean(xf * xf, axis=-1, keepdims=True) + EPS)
    return (y * g.astype(jnp.float32)).astype(x.dtype)


def rel_dist(n_q, n_k, n_before):
    return jnp.arange(n_q)[:, None] + n_before - jnp.arange(n_k)[None, :]


def alibi_bias(dist):
    slopes = 2.0 ** (-8.0 * jnp.arange(1, A_HEADS + 1, dtype=jnp.float32) / A_HEADS)
    b = -slopes[:, None, None] * jnp.abs(dist).astype(jnp.float32)[None]
    return b.reshape(A_KV_HEADS, A_GROUP, dist.shape[0], dist.shape[1])


def rel_bias(table, dist):
    idx = jnp.clip(dist, -REL_CLIP, REL_CLIP) + REL_CLIP
    return jnp.transpose(table[idx].astype(jnp.float32), (2, 0, 1))[:, None]


def attend(q, k, v, bias, sink):
    s = jnp.einsum('bqngd,bknd->bngqk', q, k, preferred_element_type=jnp.float32) * (HEAD_DIM ** -0.5) + bias
    if sink is not None:
        col = jnp.broadcast_to(sink.astype(jnp.float32)[:, :, None, None], s.shape[:-1] + (1,))
        p = jax.nn.softmax(jnp.concatenate([s, col], axis=-1), axis=-1)[..., :-1]
    else:
        p = jax.nn.softmax(s, axis=-1)
    return jnp.einsum('bngqk,bknd->bqngd', p.astype(v.dtype), v)


def band_prompt(q, k, v, n_prev, bias, sink):
    b, s = q.shape[:2]
    n_chunks = s // CHUNK
    reach = n_prev * CHUNK
    span = reach + CHUNK
    pad = ((0, 0), (reach, 0), (0, 0), (0, 0))
    kp, vp = jnp.pad(k, pad), jnp.pad(v, pad)
    qc = jnp.swapaxes(q.reshape((b, n_chunks, CHUNK) + q.shape[2:]), 0, 1)

    def one_chunk(args):
        c, qi = args
        start = c * CHUNK
        kb = lax.dynamic_slice_in_dim(kp, start, span, axis=1)
        vb = lax.dynamic_slice_in_dim(vp, start, span, axis=1)
        valid = start - reach + jnp.arange(span) >= 0
        return attend(qi, kb, vb, jnp.where(valid, bias, NEG_INF), sink)

    out = lax.map(one_chunk, (jnp.arange(n_chunks), qc))
    return jnp.swapaxes(out, 0, 1).reshape(b, s, -1)


def project(h, w_in, b_gate, qa_g, ka_g, qb_g, kb_g):
    b, t = h.shape[:2]
    z = h @ w_in
    qa, ka, va, qb, kb, vb, ga, gb = jnp.split(z, SPLITS, axis=-1)
    heads = lambda u, n: u.reshape(b, t, n, HEAD_DIM)
    qa = rmsnorm(heads(qa, A_HEADS), qa_g).reshape(b, t, A_KV_HEADS, A_GROUP, HEAD_DIM)
    ka = rmsnorm(heads(ka, A_KV_HEADS), ka_g)
    va = heads(va, A_KV_HEADS)
    qb = rmsnorm(heads(qb, B_HEADS), qb_g)[:, :, :, None]
    kb = rmsnorm(heads(kb, B_HEADS), kb_g)
    vb = heads(vb, B_HEADS)
    ga = jax.nn.sigmoid(ga + b_gate[:D_MODEL])
    gb = jax.nn.sigmoid(gb + b_gate[D_MODEL:])
    return qa, ka, va, qb, kb, vb, ga, gb


def conv_ffn(h, w_up, conv_w, conv_b, w_down, prev):
    u = h @ w_up
    t = u.shape[1]
    up = jnp.concatenate([prev.astype(u.dtype), u], axis=1)
    c = conv_b + conv_w[0] * up[:, 0:t]
    for j in range(1, CONV_W):
        c = c + conv_w[j] * up[:, j:j + t]
    a, g = jnp.split(c, 2, axis=-1)
    return (jax.nn.gelu(a, approximate=False) * g) @ w_down, up[:, -(CONV_W - 1):]


def trunk_layer(x, p, cache):
    (n1, w_in, b_gate, qa_g, ka_g, qb_g, kb_g, sinks, table,
     w_out, n2, w_up, conv_w, conv_b, w_down) = p
    b, t, _ = x.shape
    h = rmsnorm(x, n1)
    qa, ka, va, qb, kb, vb, ga, gb = project(h, w_in, b_gate, qa_g, ka_g, qb_g, kb_g)
    sink = sinks.reshape(A_KV_HEADS, A_GROUP)
    if cache is None:
        span_a, span_b = (A_PREV + 1) * CHUNK, (B_PREV + 1) * CHUNK
        oa = band_prompt(qa, ka, va, A_PREV, alibi_bias(rel_dist(CHUNK, span_a, A_PREV * CHUNK)), sink)
        ob = band_prompt(qb, kb, vb, B_PREV, rel_bias(table, rel_dist(CHUNK, span_b, B_PREV * CHUNK)), None)
        conv_prev = jnp.zeros((b, CONV_W - 1, 2 * D_FF), x.dtype)
        wa, wb = min(A_WINDOW, t), min(B_REACH, t)
        new_kv = (ka[:, -wa:], va[:, -wa:], kb[:, -wb:], vb[:, -wb:])
    else:
        cak, cav, cbk, cbv, conv_prev = cache
        wa, wb = cak.shape[1], cbk.shape[1]
        oa = attend(qa, jnp.concatenate([cak.astype(ka.dtype), ka], axis=1),
                    jnp.concatenate([cav.astype(va.dtype), va], axis=1),
                    alibi_bias(rel_dist(t, wa + t, wa)), sink)
        ob = attend(qb, jnp.concatenate([cbk.astype(kb.dtype), kb], axis=1),
                    jnp.concatenate([cbv.astype(vb.dtype), vb], axis=1),
                    rel_bias(table, rel_dist(t, wb + t, wb)), None)
        new_kv = (ka, va, kb, vb)
    mixed = ga * oa.reshape(b, t, D_MODEL) + gb * ob.reshape(b, t, D_MODEL)
    x = x + mixed @ w_out
    f, conv_state = conv_ffn(rmsnorm(x, n2), w_up, conv_w, conv_b, w_down, conv_prev)
    x = x + f
    return x, (new_kv[0], new_kv[1], new_kv[2], new_kv[3], conv_state)


def setup_inputs(seed: int = 0) -> dict:
    key = jax.random.key(seed)
    ks = jax.random.split(key, 22)
    nrm = lambda k, shape, scale: scale * jax.random.normal(k, shape, jnp.float32)
    wa, wb = min(A_WINDOW, PAST_LEN), min(B_REACH, PAST_LEN)
    return {
        'x_prompt': nrm(ks[0], (BATCH, SEQ, D_MODEL), 1.0),
        'x_sample': nrm(ks[1], (DEC_BATCH, DEC_SEQ, D_MODEL), 1.0),
        'cache_a_k': nrm(ks[2], (DEPTH, DEC_BATCH, wa, A_KV_HEADS, HEAD_DIM), 1.0),
        'cache_a_v': nrm(ks[3], (DEPTH, DEC_BATCH, wa, A_KV_HEADS, HEAD_DIM), 1.0),
        'cache_b_k': nrm(ks[4], (DEPTH, DEC_BATCH, wb, B_HEADS, HEAD_DIM), 1.0),
        'cache_b_v': nrm(ks[5], (DEPTH, DEC_BATCH, wb, B_HEADS, HEAD_DIM), 1.0),
        'cache_ffn_conv': nrm(ks[6], (DEPTH, DEC_BATCH, CONV_W - 1, 2 * D_FF), 1.0),
        'norm1_g': 1.0 + nrm(ks[7], (DEPTH, D_MODEL), 0.02),
        'w_in': nrm(ks[8], (DEPTH, D_MODEL, N_IN), D_MODEL ** -0.5),
        'b_gate': nrm(ks[9], (DEPTH, 2 * D_MODEL), 0.02),
        'qn_a_g': 1.0 + nrm(ks[10], (DEPTH, HEAD_DIM), 0.02),
        'kn_a_g': 1.0 + nrm(ks[11], (DEPTH, HEAD_DIM), 0.02),
        'qn_b_g': 1.0 + nrm(ks[12], (DEPTH, HEAD_DIM), 0.02),
        'kn_b_g': 1.0 + nrm(ks[13], (DEPTH, HEAD_DIM), 0.02),
        'sinks_a': nrm(ks[14], (DEPTH, A_HEADS), 0.5),
        'rel_bias_b': nrm(ks[15], (DEPTH, N_REL, B_HEADS), 0.1),
        'w_out': nrm(ks[16], (DEPTH, D_MODEL, D_MODEL), D_MODEL ** -0.5),
        'norm2_g': 1.0 + nrm(ks[17], (DEPTH, D_MODEL), 0.02),
        'w_up': nrm(ks[18], (DEPTH, D_MODEL, 2 * D_FF), D_MODEL ** -0.5),
        'conv_w': nrm(ks[19], (DEPTH, CONV_W, 2 * D_FF), CONV_W ** -0.5),
        'conv_b': nrm(ks[20], (DEPTH, 2 * D_FF), 0.02),
        'w_down': nrm(ks[21], (DEPTH, D_FF, D_MODEL), D_FF ** -0.5),
    }


def reference(x_prompt, x_sample, cache_a_k, cache_a_v, cache_b_k, cache_b_v, cache_ffn_conv,
              norm1_g, w_in, b_gate, qn_a_g, kn_a_g, qn_b_g, kn_b_g, sinks_a, rel_bias_b,
              w_out, norm2_g, w_up, conv_w, conv_b, w_down):
    xp, xs = x_prompt, x_sample
    sp, ss = [], []
    for l in range(DEPTH):
        p = (norm1_g[l], w_in[l], b_gate[l], qn_a_g[l], kn_a_g[l], qn_b_g[l], kn_b_g[l],
             sinks_a[l], rel_bias_b[l], w_out[l], norm2_g[l], w_up[l], conv_w[l], conv_b[l], w_down[l])
        xp, st_p = trunk_layer(xp, p, None)
        sp.append(st_p)
        xs, st_s = trunk_layer(xs, p, (cache_a_k[l], cache_a_v[l], cache_b_k[l], cache_b_v[l],
                                       cache_ffn_conv[l]))
        ss.append(st_s)
    stk = lambda states, i: jnp.stack([s[i] for s in states])
    return (xp, xs,
            stk(sp, 0), stk(sp, 1), stk(sp, 2), stk(sp, 3), stk(sp, 4),
            stk(ss, 0), stk(ss, 1), stk(ss, 2), stk(ss, 3), stk(ss, 4))
```

```cpp
#include <hip/hip_runtime.h>
#include <hip/hip_cooperative_groups.h>
#include <cstdio>
#include <cstdint>
namespace cg = cooperative_groups;

#define LAS __attribute__((address_space(3)))
typedef unsigned short bf16_t;
typedef short bf16x8 __attribute__((ext_vector_type(8)));
typedef float f32x4 __attribute__((ext_vector_type(4)));
typedef float f32x2 __attribute__((ext_vector_type(2)));
typedef float f32x16 __attribute__((ext_vector_type(16)));
typedef unsigned u32x4 __attribute__((ext_vector_type(4)));
typedef unsigned u32x2 __attribute__((ext_vector_type(2)));
typedef __bf16 bf16x2_t __attribute__((ext_vector_type(2)));

constexpr int DM = 1024, MP = 16384, MS = 256, MT = MP + MS, SEQ = 4096, NBATCH = 4, SBATCH = 8, STOK = 32;
constexpr int NIN = 6656, NQKV = 4608, DFF = 2816, NUP = 5632, DEPTH = 2;
constexpr int NT32 = SEQ / 32;
constexpr int NBS_A = 5, NBS_B = 17;
constexpr float EPS = 1e-6f, LOG2E = 1.4426950408889634f;

constexpr size_t O_YP = 0, O_YS = 16777216, O_PAK = 17039360, O_PAV = 17301504, O_PBK = 17563648, O_PBV = 21757952,
                 O_PFC = 25952256, O_SAK = 26042368, O_SAV = 26173440, O_SBK = 26304512, O_SBV = 26828800, O_SFC = 27353088,
                 O_END = 27533312;
constexpr size_t MiB = 1u << 20;
constexpr size_t WS_WIN = 1 * MiB, WS_WOUT = 14 * MiB, WS_WUP = 16 * MiB, WS_WDN = 27 * MiB, WS_XN = 33 * MiB, WS_QA = 66 * MiB, WS_QB = 99 * MiB,
                 WS_KA = 132 * MiB, WS_VA = 140 * MiB, WS_KB = 148 * MiB, WS_VB = 180 * MiB, WS_KAS = 212 * MiB, WS_VAS = 213 * MiB,
                 WS_KBS = 214 * MiB, WS_VBS = 223 * MiB, WS_ACT = 66 * MiB, WS_HU = 156 * MiB, WS_US = 178 * MiB, WS_END = 232 * MiB;

struct Params { const float* in[22]; float* out; unsigned char* ws; };

__device__ __forceinline__ unsigned cvt_pk_bf16(float lo, float hi) { f32x2 v = {lo, hi}; bf16x2_t b = __builtin_convertvector(v, bf16x2_t); return __builtin_bit_cast(unsigned, b); }
__device__ __forceinline__ float bf2f(unsigned short b) { return __builtin_bit_cast(float, (unsigned)b << 16); }

__device__ __forceinline__ int phase_tid(int wave_s) { int lane; asm volatile("v_mbcnt_lo_u32_b32 %0, -1, 0\n\tv_mbcnt_hi_u32_b32 %0, -1, %0" : "=v"(lane)); return wave_s * 64 + lane; }
namespace pg8 {
constexpr int BM = 256, BK = 64, HALF = 128, HTB = HALF * BK * 2, STAGE_BYTES = 8 * HTB, NXCD = 8, WGM = 8;
__host__ __device__ __forceinline__ int lds_byte(int r, int c) { const int st = (r >> 4) * 2 + (c >> 5), rr = r & 15, cc = c & 31, ob = rr * 64 + cc * 2; return st * 1024 + (ob ^ (((ob >> 9) & 1) << 5)); }
__host__ __device__ __forceinline__ void stage_rc(int b, int& R, int& C) { const int st = b / 1024, sb = b % 1024, swz = sb ^ (((sb >> 9) & 1) << 5); R = (st >> 1) * 16 + swz / 64; C = (st & 1) * 32 + (swz % 64) / 2; }
__host__ __device__ __forceinline__ int perm32(int rho) { const int n = rho >> 4, i = rho & 15; return 8 * (i >> 2) + 4 * n + (i & 3); }

struct Unit { int pm, pn; };
struct Gemm { const bf16_t* A; const bf16_t* Bt; int M, N, K; };

struct StaticOrder {
    int nM, nN, nwg, G, c;
    __device__ void init(int M, int N, int G_, int c_) { nM = M / BM; nN = N / BM; nwg = nM * nN; G = G_; c = c_; }
    __device__ bool next(int i, Unit& u) const {
        const long L = (long)i * G + c; if (L >= nwg) return false;
        int wgid = (int)L; { const int q = nwg / NXCD, r = nwg % NXCD, xcd = wgid % NXCD, off = wgid / NXCD; wgid = (xcd < r ? xcd * (q + 1) : r * (q + 1) + (xcd - r) * q) + off; }
        const int nig = WGM * nN, gid = wgid / nig, fm = gid * WGM, gsz = (nM - fm) < WGM ? (nM - fm) : WGM;
        u.pm = fm + ((wgid % nig) % gsz); u.pn = (wgid % nig) / gsz; return true;
    }
};

template <class Epi>
__device__ __forceinline__ void gemm_phase(LAS unsigned char* lds, Gemm g, const StaticOrder& S, const Epi& E, int wave_s) {
    int tid_ = phase_tid(wave_s);
    asm volatile("" : "+s"(g.A), "+s"(g.Bt));
    const int tid = tid_, wid = __builtin_amdgcn_readfirstlane(tid >> 6), lane = tid & 63, wr = wid >> 2, wc = wid & 3, fr = lane & 15, fq = lane >> 4;
    const int K = g.K, nt = K / BK;
    unsigned voffA[2], voffB[2];
#pragma unroll
    for (int i = 0; i < 2; ++i) { int R, C; stage_rc(tid * 16 + i * 8192, R, C); const int Rb = (R & ~31) + perm32(R & 31);
        const int Ra = Epi::APERM ? ((R & ~63) + 4 * (R & 15) + ((R >> 4) & 3)) : R;
        voffA[i] = (unsigned)(Ra * K + C) * 2u; voffB[i] = (unsigned)(Rb * K + C) * 2u; }
    const size_t kstep = (size_t)(BK * 2);
    const size_t hstep = (size_t)HALF * K * 2;
    const size_t tstep = 2 * hstep;
    const unsigned ldsw = (unsigned)wid * 1024u;
    const int aoff = lds_byte(wr * 64 + fr, fq * 8), boff = lds_byte(wc * 32 + fr, fq * 8);
#define PG8_SA(b, h) (((b) * 2 + (h)) * HTB)
#define PG8_SB(b, h) ((4 + (b) * 2 + (h)) * HTB)
#define PG8_STAGE(bufoff, gbase, voff) do { _Pragma("unroll") for (int _i = 0; _i < 2; ++_i) \
        __builtin_amdgcn_global_load_lds((const unsigned*)((const char*)(gbase) + (voff)[_i]), (LAS unsigned*)(lds + (bufoff) + ldsw + _i * 8192), 16, 0, 0); } while (0)
#define PG8_LDA(dst, b, h) do { _Pragma("unroll") for (int m = 0; m < 4; ++m) _Pragma("unroll") for (int k = 0; k < 2; ++k) dst[m][k] = *(const LAS bf16x8*)(lds + PG8_SA(b, h) + aoff + m * 2048 + k * 1024); } while (0)
#define PG8_LDB(dst, b, h) do { _Pragma("unroll") for (int n = 0; n < 2; ++n) _Pragma("unroll") for (int k = 0; k < 2; ++k) dst[n][k] = *(const LAS bf16x8*)(lds + PG8_SB(b, h) + boff + n * 2048 + k * 1024); } while (0)
#define PG8_MMA(ai, bj, At, Bt) do { __builtin_amdgcn_s_setprio(1); _Pragma("unroll") for (int m = 0; m < 4; ++m) _Pragma("unroll") for (int n = 0; n < 2; ++n) _Pragma("unroll") for (int k = 0; k < 2; ++k) \
        acc[ai][bj][m][n] = __builtin_amdgcn_mfma_f32_16x16x32_bf16(Bt[n][k], At[m][k], acc[ai][bj][m][n], 0, 0, 0); __builtin_amdgcn_s_setprio(0); } while (0)
#define PG8_WAIT_V(n) asm volatile("s_waitcnt vmcnt(" #n ")" ::: "memory")
#define PG8_WAIT_L(n) asm volatile("s_waitcnt lgkmcnt(" #n ")" ::: "memory")
#define PG8_BAR __builtin_amdgcn_s_barrier()
#define PG8_SCHED __builtin_amdgcn_sched_barrier(0)
    Unit cur, nxt; int ui = 0;
    if (!S.next(0, cur)) return;
    f32x4 acc[2][2][4][2];
#pragma unroll
    for (int a = 0; a < 2; ++a)
#pragma unroll
        for (int b = 0; b < 2; ++b)
#pragma unroll
            for (int m = 0; m < 4; ++m)
#pragma unroll
                for (int n = 0; n < 2; ++n) acc[a][b][m][n] = (f32x4){0.f, 0.f, 0.f, 0.f};
    bf16x8 At[4][2], B0[2][2], B1[2][2];
    const char* cA = (const char*)g.A + (size_t)cur.pm * tstep; const char* cB = (const char*)g.Bt + (size_t)cur.pn * tstep;
    PG8_STAGE(PG8_SB(0, 0), cB, voffB); PG8_STAGE(PG8_SB(0, 1), cB + hstep, voffB); PG8_STAGE(PG8_SA(0, 0), cA, voffA); PG8_STAGE(PG8_SA(0, 1), cA + hstep, voffA);
    if (wr == 1) PG8_BAR;
    PG8_WAIT_V(2); PG8_BAR;
    PG8_STAGE(PG8_SB(1, 0), cB + kstep, voffB); PG8_STAGE(PG8_SA(1, 0), cA + kstep, voffA); PG8_STAGE(PG8_SB(1, 1), cB + hstep + kstep, voffB);
    PG8_WAIT_V(6); PG8_BAR;
    for (;;) {
        const bool has_next = S.next(ui + 1, nxt);
        const char* nA = has_next ? (const char*)g.A + (size_t)nxt.pm * tstep : cA; const char* nB = has_next ? (const char*)g.Bt + (size_t)nxt.pn * tstep : cB;
        for (int t = 0; t < nt; t += 2) {
            const bool last = (t == nt - 2);
            const char* a1 = cA + (size_t)(t + 1) * kstep;
            const char* a2 = last ? nA : cA + (size_t)(t + 2) * kstep; const char* b2 = last ? nB : cB + (size_t)(t + 2) * kstep;
            const char* a3 = a2 + kstep; const char* b3 = b2 + kstep;
            PG8_LDB(B0, 0, 0); PG8_LDB(B1, 0, 1); PG8_SCHED; PG8_LDA(At, 0, 0); PG8_STAGE(PG8_SA(1, 1), a1 + hstep, voffA);
            PG8_WAIT_V(8); PG8_WAIT_L(0); PG8_BAR; PG8_MMA(0, 0, At, B0); PG8_MMA(0, 1, At, B1); PG8_BAR; PG8_SCHED;
            PG8_LDA(At, 0, 1); PG8_STAGE(PG8_SB(0, 0), b2, voffB); PG8_STAGE(PG8_SB(0, 1), b2 + hstep, voffB); PG8_STAGE(PG8_SA(0, 0), a2, voffA);
            PG8_WAIT_V(8); PG8_WAIT_L(0); PG8_BAR; PG8_MMA(1, 0, At, B0); PG8_MMA(1, 1, At, B1); PG8_BAR; PG8_SCHED;
            PG8_LDB(B0, 1, 0); PG8_LDB(B1, 1, 1); PG8_SCHED; PG8_LDA(At, 1, 0); PG8_STAGE(PG8_SA(0, 1), a2 + hstep, voffA);
            PG8_WAIT_V(8); PG8_WAIT_L(0); PG8_BAR; PG8_MMA(0, 0, At, B0); PG8_MMA(0, 1, At, B1); PG8_BAR; PG8_SCHED;
            PG8_LDA(At, 1, 1); PG8_STAGE(PG8_SB(1, 0), b3, voffB); PG8_STAGE(PG8_SB(1, 1), b3 + hstep, voffB); PG8_STAGE(PG8_SA(1, 0), a3, voffA);
            PG8_WAIT_V(8); PG8_WAIT_L(0); PG8_BAR; PG8_MMA(1, 0, At, B0); PG8_MMA(1, 1, At, B1); PG8_BAR; PG8_SCHED;
        }
        if (wr == 0) PG8_BAR;
        E(acc, cur, wr, wc, fr, fq);
        if (!has_next) break;
#pragma unroll
        for (int a = 0; a < 2; ++a)
#pragma unroll
            for (int b = 0; b < 2; ++b)
#pragma unroll
                for (int m = 0; m < 4; ++m)
#pragma unroll
                    for (int n = 0; n < 2; ++n) acc[a][b][m][n] = (f32x4){0.f, 0.f, 0.f, 0.f};
        cur = nxt; cA = nA; cB = nB; ++ui;
        if (wr == 1) PG8_BAR;
    }
    PG8_WAIT_V(0);
    PG8_BAR;
#undef PG8_SA
#undef PG8_SB
#undef PG8_STAGE
#undef PG8_LDA
#undef PG8_LDB
#undef PG8_MMA
#undef PG8_WAIT_V
#undef PG8_WAIT_L
#undef PG8_BAR
#undef PG8_SCHED
}
}
using pg8::Unit;
typedef const f32x4 (&AccRef)[2][2][4][2];

__device__ __forceinline__ float gelu1(float v) {
    const float av = __builtin_fabsf(v), d = av * 0.2316418882f + 1.0f;
    const float t = __builtin_amdgcn_rcpf(d);
    float q = t * 0.5307027145f + (-0.7265760135f); q = q * t + 0.7107068705f; q = q * t + (-0.142248368f); q = q * t + 0.127414796f; q = q * t;
    const float e = __builtin_amdgcn_exp2f((v * v) * (-0.72134752044f));
    const float m = v * (q * e), r = v - m;
    return v < 0.f ? m : r;
}
__device__ __forceinline__ float sigmoidf_(float x) { return __builtin_amdgcn_rcpf(1.0f + __builtin_amdgcn_exp2f(-x * LOG2E)); }

struct EpiG1a {
    static constexpr bool APERM = false;
    unsigned char* ws; float* out; const float *gqa, *gka, *gqb, *gkb; int l;
    __device__ __forceinline__ void operator()(AccRef acc, const Unit& u, int wr, int wc, int fr, int fq) const {
        asm volatile("" : "+v"(fr), "+v"(fq));
        const int pn = u.pn; const bool samp = (u.pm == 64);
        int ty, hs, mb;
        if (pn < 4) { ty = 0; mb = 0; hs = pn * 4 + wc; } else if (pn == 4) { ty = 1; mb = 0; hs = wc; } else if (pn == 5) { ty = 2; mb = 0; hs = wc; }
        else if (pn < 10) { ty = 0; mb = 1; hs = (pn - 6) * 4 + wc; } else if (pn < 14) { ty = 1; mb = 1; hs = (pn - 10) * 4 + wc; } else { ty = 2; mb = 1; hs = (pn - 14) * 4 + wc; }
        if (ty == 0) {
            bf16_t* Q = (bf16_t*)(ws + (mb ? WS_QB : WS_QA)); const float* gg = mb ? gqb : gqa;
            f32x4 gv[2][2];
#pragma unroll
            for (int bj = 0; bj < 2; ++bj)
#pragma unroll
                for (int n = 0; n < 2; ++n) gv[bj][n] = *(const f32x4*)(gg + 32 * bj + 8 * fq + 4 * n);
#pragma unroll
            for (int ai = 0; ai < 2; ++ai)
#pragma unroll
                for (int m = 0; m < 4; ++m) {
                    float ss = 0.f;
#pragma unroll
                    for (int bj = 0; bj < 2; ++bj)
#pragma unroll
                        for (int n = 0; n < 2; ++n) { const f32x4 x = acc[ai][bj][m][n]; ss += (x[0] * x[0] + x[1] * x[1]) + (x[2] * x[2] + x[3] * x[3]); }
                    ss += __shfl_xor(ss, 16); ss += __shfl_xor(ss, 32);
                    const float rs = __builtin_amdgcn_rsqf(ss * (1.0f / 64.0f) + EPS);
                    const size_t row = (size_t)u.pm * 256 + ai * 128 + wr * 64 + m * 16 + fr;
                    bf16_t* qp = Q + row * DM + hs * 64 + 8 * fq;
#pragma unroll
                    for (int bj = 0; bj < 2; ++bj) {
                        const f32x4 a = acc[ai][bj][m][0] * rs * gv[bj][0], b = acc[ai][bj][m][1] * rs * gv[bj][1];
                        u32x4 w; w.x = cvt_pk_bf16(a[0], a[1]); w.y = cvt_pk_bf16(a[2], a[3]); w.z = cvt_pk_bf16(b[0], b[1]); w.w = cvt_pk_bf16(b[2], b[3]);
                        *(u32x4*)(qp + 32 * bj) = w;
                    }
                }
            return;
        }
        const int H = mb ? 16 : 4, W = mb ? 512 : 128, NBS = mb ? NBS_B : NBS_A;
        bf16_t* KVp = (bf16_t*)(ws + ((ty == 1) ? (mb ? WS_KB : WS_KA) : (mb ? WS_VB : WS_VA)));
        bf16_t* KVs = (bf16_t*)(ws + ((ty == 1) ? (mb ? WS_KBS : WS_KAS) : (mb ? WS_VBS : WS_VAS)));
        float* op = out + ((ty == 1) ? (mb ? O_PBK : O_PAK) : (mb ? O_PBV : O_PAV)) + (size_t)l * NBATCH * W * H * 64;
        float* os = out + ((ty == 1) ? (mb ? O_SBK : O_SAK) : (mb ? O_SBV : O_SAV)) + (size_t)l * SBATCH * STOK * H * 64;
        f32x4 gv[2][2];
#pragma unroll
        for (int bj = 0; bj < 2; ++bj)
#pragma unroll
            for (int n = 0; n < 2; ++n) gv[bj][n] = (ty == 1) ? *(const f32x4*)((mb ? gkb : gka) + 32 * bj + 8 * fq + 4 * n) : (f32x4){1.f, 1.f, 1.f, 1.f};
#pragma unroll
        for (int ai = 0; ai < 2; ++ai)
#pragma unroll
            for (int m = 0; m < 4; ++m) {
                float rs = 1.0f;
                if (ty == 1) {
                    float ss = 0.f;
#pragma unroll
                    for (int bj = 0; bj < 2; ++bj)
#pragma unroll
                        for (int n = 0; n < 2; ++n) { const f32x4 x = acc[ai][bj][m][n]; ss += (x[0] * x[0] + x[1] * x[1]) + (x[2] * x[2] + x[3] * x[3]); }
                    ss += __shfl_xor(ss, 16); ss += __shfl_xor(ss, 32);
                    rs = __builtin_amdgcn_rsqf(ss * (1.0f / 64.0f) + EPS);
                }
                const int rloc = ai * 128 + wr * 64 + m * 16 + fr;
                int b, t, kidx; bf16_t* blk; float* fo = nullptr;
                if (!samp) { b = u.pm >> 4; t = (u.pm & 15) * 256 + rloc; kidx = t; blk = KVp + ((size_t)(b * H + hs) * NT32 + (t >> 5)) * 2048;
                    if (t >= SEQ - W) fo = op + ((size_t)(b * W + (t - (SEQ - W))) * H + hs) * 64; }
                else { b = rloc >> 5; t = rloc & 31; kidx = W + t; blk = KVs + ((size_t)(b * H + hs) * NBS + (kidx >> 5)) * 2048;
                    fo = os + ((size_t)(b * STOK + t) * H + hs) * 64; }
                const int tt = kidx & 31;
#pragma unroll
                for (int bj = 0; bj < 2; ++bj) {
                    const f32x4 a = acc[ai][bj][m][0] * rs * gv[bj][0], c = acc[ai][bj][m][1] * rs * gv[bj][1];
                    if (fo) { *(f32x4*)(fo + 32 * bj + 8 * fq) = a; *(f32x4*)(fo + 32 * bj + 8 * fq + 4) = c; }
                    if (ty == 1) {
                        u32x4 w; w.x = cvt_pk_bf16(a[0], a[1]); w.y = cvt_pk_bf16(a[2], a[3]); w.z = cvt_pk_bf16(c[0], c[1]); w.w = cvt_pk_bf16(c[2], c[3]);
                        *(u32x4*)(blk + ((fq * 2 + bj) * 32 + tt) * 8) = w;
                    } else {
                        const int s = tt >> 4, u16 = tt & 15, hi = (u16 >> 2) & 1, j = (u16 & 3) + 4 * (u16 >> 3);
                        bf16_t* vp = blk + (((s * 2 + bj) * 2 + hi) * 32 + 8 * fq) * 8 + j;
                        const unsigned p0 = cvt_pk_bf16(a[0], a[1]), p1 = cvt_pk_bf16(a[2], a[3]), p2 = cvt_pk_bf16(c[0], c[1]), p3 = cvt_pk_bf16(c[2], c[3]);
                        vp[0] = (bf16_t)p0; vp[8] = (bf16_t)(p0 >> 16); vp[16] = (bf16_t)p1; vp[24] = (bf16_t)(p1 >> 16);
                        vp[32] = (bf16_t)p2; vp[40] = (bf16_t)(p2 >> 16); vp[48] = (bf16_t)p3; vp[56] = (bf16_t)(p3 >> 16);
                    }
                }
                asm volatile("" ::: "memory");
            }
    }
};
struct EpiG1b {
    static constexpr bool APERM = false;
    bf16_t *OA; const bf16_t* OB; const float* bg;
    __device__ __forceinline__ void operator()(AccRef acc, const Unit& u, int wr, int wc, int fr, int fq) const {
        asm volatile("" : "+v"(fr), "+v"(fq));
        const int c0 = u.pn * 128 + wc * 32 + 8 * fq;
        f32x4 ba[2], bb[2];
#pragma unroll
        for (int n = 0; n < 2; ++n) { ba[n] = *(const f32x4*)(bg + c0 + 4 * n); bb[n] = *(const f32x4*)(bg + DM + c0 + 4 * n); }
#pragma unroll
        for (int ai = 0; ai < 2; ++ai)
#pragma unroll
            for (int m = 0; m < 4; ++m) {
                const size_t off = ((size_t)u.pm * 256 + ai * 128 + wr * 64 + m * 16 + fr) * DM + c0;
                const u32x4 oa = *(const u32x4*)(OA + off), ob = *(const u32x4*)(OB + off);
                float r[8];
#pragma unroll
                for (int n = 0; n < 2; ++n)
#pragma unroll
                    for (int e = 0; e < 4; ++e) {
                        const int j = 4 * n + e; const unsigned wa = oa[j >> 1], wb = ob[j >> 1];
                        const float fa = (j & 1) ? __builtin_bit_cast(float, wa & 0xffff0000u) : __builtin_bit_cast(float, wa << 16);
                        const float fb = (j & 1) ? __builtin_bit_cast(float, wb & 0xffff0000u) : __builtin_bit_cast(float, wb << 16);
        #ifdef DBG_NOATT
                        r[j] = 0.f;
#else
                        r[j] = sigmoidf_(acc[ai][0][m][n][e] + ba[n][e]) * fa + sigmoidf_(acc[ai][1][m][n][e] + bb[n][e]) * fb;
#endif
                    }
                u32x4 w; w.x = cvt_pk_bf16(r[0], r[1]); w.y = cvt_pk_bf16(r[2], r[3]); w.z = cvt_pk_bf16(r[4], r[5]); w.w = cvt_pk_bf16(r[6], r[7]);
                *(u32x4*)(OA + off) = w;
                asm volatile("" ::: "memory");
            }
    }
};
struct EpiRes {
    static constexpr bool APERM = false;
    const float* xin_p; const float* xin_s; float* xout; float scale;
    float oscale_p;
    __device__ __forceinline__ void operator()(AccRef acc, const Unit& u, int wr, int wc, int fr, int fq) const {
        asm volatile("" : "+v"(fr), "+v"(fq));
        const float* xb = (u.pm < 64) ? xin_p + (size_t)u.pm * 256 * DM : xin_s;
        const float oscale = (u.pm < 64) ? oscale_p : 1.0f;
        float* ob = xout + (size_t)u.pm * 256 * DM;
#pragma unroll
        for (int ai = 0; ai < 2; ++ai)
#pragma unroll
            for (int m = 0; m < 4; ++m) {
                const size_t off = (size_t)(ai * 128 + wr * 64 + m * 16 + fr) * DM + u.pn * 256 + wc * 32 + 8 * fq;
#pragma unroll
                for (int bj = 0; bj < 2; ++bj)
#pragma unroll
                    for (int n = 0; n < 2; ++n) { const f32x4 x = *(const f32x4*)(xb + off + bj * 128 + 4 * n); *(f32x4*)(ob + off + bj * 128 + 4 * n) = (x + acc[ai][bj][m][n] * scale) * oscale; }
                asm volatile("" ::: "memory");
            }
    }
};
__device__ __forceinline__ float dpp_shr1(float x) { return __builtin_bit_cast(float, __builtin_amdgcn_update_dpp(0, __builtin_bit_cast(int, x), 0x111  , 0xf, 0xf, false)); }
__device__ __forceinline__ f32x4 dpp_prev_lane(f32x4 v) {
    const float a = dpp_shr1(v.x), b = dpp_shr1(v.y), c = dpp_shr1(v.z), d = dpp_shr1(v.w);
    return (f32x4){a, b, c, d};
}
struct EpiG3 {
    static constexpr bool APERM = true;
    unsigned char* ws; float* o_pfc; const float* cw; const float* cb;
    __device__ __forceinline__ void operator()(AccRef acc, const Unit& u, int wr, int wc, int fr, int fq) const {
        asm volatile("" : "+v"(fr), "+v"(fq));
        bf16_t* ACT = (bf16_t*)(ws + WS_ACT); float* HU = (float*)(ws + WS_HU); float* US = (float*)(ws + WS_US);
        const int ca0 = u.pn * 128 + wc * 32 + 8 * fq;
        if (u.pm == 64) {
#pragma unroll
            for (int ai = 0; ai < 2; ++ai)
#pragma unroll
                for (int m = 0; m < 4; ++m) { float* p = US + (size_t)(ai * 128 + wr * 64 + 4 * fr + m) * NUP + ca0;
#pragma unroll
                    for (int bj = 0; bj < 2; ++bj)
#pragma unroll
                        for (int n = 0; n < 2; ++n) *(f32x4*)(p + bj * DFF + 4 * n) = acc[ai][bj][m][n]; }
            return;
        }
#pragma unroll
        for (int ai = 0; ai < 2; ++ai) {
            const int seg = u.pm * 4 + ai * 2 + wr;
            const size_t row0 = (size_t)u.pm * 256 + ai * 128 + wr * 64 + 4 * fr;
            const bool lastseg = ((u.pm & 15) == 15) && ai == 1 && wr == 1;
#pragma unroll
            for (int n = 0; n < 2; ++n) {
                f32x4 cg[4];
#pragma unroll
                for (int bj = 1; bj >= 0; --bj) {
                    const int col = bj * DFF + ca0 + 4 * n;
                    const f32x4 w0 = *(const f32x4*)(cw + col), w1 = *(const f32x4*)(cw + NUP + col), w2 = *(const f32x4*)(cw + 2 * NUP + col), bb = *(const f32x4*)(cb + col);
                    const f32x4 x0 = acc[ai][bj][0][n], x1 = acc[ai][bj][1][n], x2 = acc[ai][bj][2][n], x3 = acc[ai][bj][3][n];
                    const f32x4 p1 = dpp_prev_lane(x3), p2 = dpp_prev_lane(x2);
                    if (fr == 0) { float* h = HU + (size_t)seg * 4 * NUP + col; *(f32x4*)h = x0; *(f32x4*)(h + NUP) = x1; }
                    if (fr == 15) { float* h = HU + (size_t)seg * 4 * NUP + 2 * NUP + col; *(f32x4*)h = x2; *(f32x4*)(h + NUP) = x3;
                        if (lastseg) { float* o = o_pfc + (size_t)(u.pm >> 4) * 2 * NUP + col; *(f32x4*)o = x2; *(f32x4*)(o + NUP) = x3; } }
                    f32x4 c[4];
                    c[0] = bb + w0 * p2 + w1 * p1 + w2 * x0;
                    c[1] = bb + w0 * p1 + w1 * x0 + w2 * x1;
                    c[2] = bb + w0 * x0 + w1 * x1 + w2 * x2;
                    c[3] = bb + w0 * x1 + w1 * x2 + w2 * x3;
                    if (bj == 1) {
#pragma unroll
                        for (int m = 0; m < 4; ++m) cg[m] = c[m];
                    } else {
#pragma unroll
                        for (int m = 0; m < 4; ++m) {
                            const float a0 = gelu1(c[m][0]) * cg[m][0], a1 = gelu1(c[m][1]) * cg[m][1], a2 = gelu1(c[m][2]) * cg[m][2], a3 = gelu1(c[m][3]) * cg[m][3];
                            u32x2 w; w.x = cvt_pk_bf16(a0, a1); w.y = cvt_pk_bf16(a2, a3);
                            *(u32x2*)(ACT + (row0 + m) * DFF + ca0 + 4 * n) = w;
                        }
                    }
                }
                asm volatile("" ::: "memory");
            }
        }
    }
};

__device__ __forceinline__ float wave_sum(float v) {
#pragma unroll
    for (int o = 1; o < 64; o <<= 1) v += __shfl_xor(v, o);
    return v;
}
__device__ __forceinline__ void transpose_item(const float* W, int K, int Nsrc, bf16_t* WT, int kb, int nb, int sb, LAS float* scr, int lane) {
    const int k0 = 64 * kb, n0 = 32 * nb, s0 = 32 * sb;
#pragma unroll 8
    for (int i = 0; i < 32; ++i) { const int kk = 2 * i + (lane >> 5); scr[kk * 33 + (lane & 31)] = W[(size_t)(k0 + kk) * Nsrc + s0 + (lane & 31)]; }
    asm volatile("s_waitcnt lgkmcnt(0)" ::: "memory");
    const int c = lane & 7;
#pragma unroll
    for (int j = 0; j < 4; ++j) { const int n = (lane >> 3) + 8 * j; const LAS float* s = scr + (8 * c) * 33 + n;
        u32x4 o; o.x = cvt_pk_bf16(s[0 * 33], s[1 * 33]); o.y = cvt_pk_bf16(s[2 * 33], s[3 * 33]); o.z = cvt_pk_bf16(s[4 * 33], s[5 * 33]); o.w = cvt_pk_bf16(s[6 * 33], s[7 * 33]);
        *(u32x4*)(WT + (size_t)(n0 + n) * K + k0 + 8 * c) = o; }
    asm volatile("s_waitcnt lgkmcnt(0)" ::: "memory");
}
__device__ __forceinline__ int win_srcblk(int nb) {
    const int pn = nb >> 3, sb = nb & 7, bj = sb >> 2, wc = sb & 3;
    if (pn < 18) return 8 * pn + 2 * wc + bj;
    return 144 + 32 * bj + 4 * (pn - 18) + wc;
}
__device__ __forceinline__ int wup_srcblk(int nb) { const int pn = nb >> 3, sb = nb & 7, bj = sb >> 2; return 88 * bj + 4 * pn + (sb & 3); }

__device__ __forceinline__ void norm_row(const float* xrow, const float* g, bf16_t* orow, int lane) {
    const f32x4* xr = (const f32x4*)xrow + lane; const f32x4* gr = (const f32x4*)g + lane;
    f32x4 v[4]; float s = 0.f;
#pragma unroll
    for (int j = 0; j < 4; ++j) { v[j] = xr[64 * j]; s += (v[j].x * v[j].x + v[j].y * v[j].y) + (v[j].z * v[j].z + v[j].w * v[j].w); }
    const float rstd = __builtin_amdgcn_rsqf(wave_sum(s) * (1.f / DM) + EPS);
    u32x2* o8 = (u32x2*)orow + lane;
#pragma unroll
    for (int j = 0; j < 4; ++j) { const f32x4 gg = gr[64 * j]; u32x2 w; w.x = cvt_pk_bf16(v[j].x * rstd * gg.x, v[j].y * rstd * gg.y); w.y = cvt_pk_bf16(v[j].z * rstd * gg.z, v[j].w * rstd * gg.w); o8[64 * j] = w; }
}
__device__ __forceinline__ void cache_convert(const float* ck, const float* cv, bf16_t* KS, bf16_t* VS, int W, int H, int NBS, int gtid, int gthreads) {
    const int nchunk = SBATCH * H * (W / 32) * 256;
    for (int id = gtid; id < 2 * nchunk; id += gthreads) {
        const bool isv = id >= nchunk; int c = isv ? id - nchunk : id;
        const int within = c & 255; c >>= 8; const int blk = c % (W / 32); c /= (W / 32); const int h = c % H, b = c / H;
        u32x4 w;
        if (!isv) { const int key = within & 31, hi = (within >> 5) & 1, d0 = within >> 6;
            const float* src = ck + ((size_t)(b * W + blk * 32 + key) * H + h) * 64 + 32 * hi + 8 * d0;
            const f32x4 a = *(const f32x4*)src, bb = *(const f32x4*)(src + 4);
            w.x = cvt_pk_bf16(a[0], a[1]); w.y = cvt_pk_bf16(a[2], a[3]); w.z = cvt_pk_bf16(bb[0], bb[1]); w.w = cvt_pk_bf16(bb[2], bb[3]);
            *(u32x4*)(KS + ((size_t)(b * H + h) * NBS + blk) * 2048 + within * 8) = w;
        } else { const int dl = within & 31, hi = (within >> 5) & 1, dblk = (within >> 6) & 1, s = within >> 7;
            float f[8];
#pragma unroll
            for (int j = 0; j < 8; ++j) { const int key = 16 * s + 4 * hi + (j & 3) + 8 * (j >> 2); f[j] = cv[((size_t)(b * W + blk * 32 + key) * H + h) * 64 + 32 * dblk + dl]; }
            w.x = cvt_pk_bf16(f[0], f[1]); w.y = cvt_pk_bf16(f[2], f[3]); w.z = cvt_pk_bf16(f[4], f[5]); w.w = cvt_pk_bf16(f[6], f[7]);
            *(u32x4*)(VS + ((size_t)(b * H + h) * NBS + blk) * 2048 + within * 8) = w;
        }
    }
}
__device__ __forceinline__ void pre_phase(const Params& P, int l, LAS unsigned char* lds, int vcu, int G, const float* xp, const float* xs, int wave_s) {
    int tid_ = phase_tid(wave_s);
    const int tid = tid_, lane = tid & 63, wave = tid >> 6;
    LAS float* scr = (LAS float*)(lds + wave * 16384);
    const int gw = vcu * 8 + wave, NGW = G * 8;
    unsigned char* ws = P.ws; asm volatile("" : "+s"(ws));
    const float* w_in = P.in[8] + (size_t)l * DM * NIN; const float* w_out = P.in[16] + (size_t)l * DM * DM;
    const float* w_up = P.in[18] + (size_t)l * DM * NUP; const float* w_dn = P.in[21] + (size_t)l * DFF * DM;
    constexpr int I_IN = 16 * (NIN / 32), I_OUT = 16 * (DM / 32), I_UP = 16 * (NUP / 32), I_DN = (DFF / 64) * (DM / 32);
    for (int it = gw; it < I_IN + I_OUT + I_UP + I_DN; it += NGW) {
        int r = it;
        if (r < I_IN) { const int nb = r % (NIN / 32), kb = r / (NIN / 32); transpose_item(w_in, DM, NIN, (bf16_t*)(ws + WS_WIN), kb, nb, win_srcblk(nb), scr, lane); continue; } r -= I_IN;
        if (r < I_OUT) { const int nb = r % 32, kb = r / 32; transpose_item(w_out, DM, DM, (bf16_t*)(ws + WS_WOUT), kb, nb, nb, scr, lane); continue; } r -= I_OUT;
        if (r < I_UP) { const int nb = r % (NUP / 32), kb = r / (NUP / 32); transpose_item(w_up, DM, NUP, (bf16_t*)(ws + WS_WUP), kb, nb, wup_srcblk(nb), scr, lane); continue; } r -= I_UP;
        { const int nb = r % 32, kb = r / 32; transpose_item(w_dn, DFF, DM, (bf16_t*)(ws + WS_WDN), kb, nb, nb, scr, lane); }
    }
    const int gtid = vcu * 512 + tid, gthreads = G * 512;
    cache_convert(P.in[2] + (size_t)l * SBATCH * 128 * 4 * 64, P.in[3] + (size_t)l * SBATCH * 128 * 4 * 64, (bf16_t*)(ws + WS_KAS), (bf16_t*)(ws + WS_VAS), 128, 4, NBS_A, gtid, gthreads);
    cache_convert(P.in[4] + (size_t)l * SBATCH * 512 * 16 * 64, P.in[5] + (size_t)l * SBATCH * 512 * 16 * 64, (bf16_t*)(ws + WS_KBS), (bf16_t*)(ws + WS_VBS), 512, 16, NBS_B, gtid, gthreads);
    const float* g1 = P.in[7] + (size_t)l * DM; bf16_t* XN = (bf16_t*)(ws + WS_XN);
    for (int m = gw; m < MT; m += NGW) norm_row(m < MP ? xp + (size_t)m * DM : xs + (size_t)(m - MP) * DM, g1, XN + (size_t)m * DM, lane);
}
__device__ __forceinline__ void norm2_phase(const Params& P, int l, int vcu, int G, int wave_s) {
    int tid_ = phase_tid(wave_s);
    const int tid = tid_, lane = tid & 63, wave = tid >> 6; const int gw = vcu * 8 + wave, NGW = G * 8;
    unsigned char* ws = P.ws; const float* x = P.out; asm volatile("" : "+s"(ws), "+s"(x));
    const float* g2 = P.in[17] + (size_t)l * DM; bf16_t* XN = (bf16_t*)(ws + WS_XN);
    for (int m = gw; m < MT; m += NGW) norm_row(x + (size_t)m * DM, g2, XN + (size_t)m * DM, lane);
}
__device__ __forceinline__ void fix_phase(const Params& P, int l, int vcu, int G, int wave_s) {
    int tid_ = phase_tid(wave_s);
    const int gtid = vcu * 512 + tid_, gthreads = G * 512;
    unsigned char* ws = P.ws; asm volatile("" : "+s"(ws));
    const float* cw = P.in[19] + (size_t)l * 3 * NUP; const float* cb = P.in[20] + (size_t)l * NUP;
    const float* HU = (const float*)(ws + WS_HU); const float* US = (const float*)(ws + WS_US); bf16_t* ACT = (bf16_t*)(ws + WS_ACT);
    const float* cprev = P.in[6] + (size_t)l * SBATCH * 2 * NUP;
    float* o_sfc = P.out + O_SFC + (size_t)l * SBATCH * 2 * NUP;
    constexpr int NPF = 256 * 2 * DFF, NSF = 256 * DFF, NSC = SBATCH * 2 * NUP;
    for (int id = gtid; id < NPF + NSF + NSC; id += gthreads) {
        if (id < NPF) {
            const int j = id % DFF, rr = (id / DFF) & 1, seg = id / (2 * DFF);
            float c2[2];
#pragma unroll
            for (int bj = 0; bj < 2; ++bj) { const int col = bj * DFF + j;
                const float* h = HU + (size_t)seg * 4 * NUP + col; const float* hp = HU + (size_t)(seg - 1) * 4 * NUP + col;
                const bool first = (seg & 63) == 0;
                const float p62 = first ? 0.f : hp[2 * NUP], p63 = first ? 0.f : hp[3 * NUP], x0 = h[0], x1 = h[NUP];
                const float w0 = cw[col], w1 = cw[NUP + col], w2 = cw[2 * NUP + col], bb = cb[col];
                c2[bj] = rr == 0 ? bb + w0 * p62 + w1 * p63 + w2 * x0 : bb + w0 * p63 + w1 * x0 + w2 * x1; }
            ACT[(size_t)(seg * 64 + rr) * DFF + j] = (bf16_t)cvt_pk_bf16(gelu1(c2[0]) * c2[1], 0.f);
        } else if (id < NPF + NSF) {
            const int r = id - NPF; const int j = r % DFF, row = r / DFF, b = row >> 5, t = row & 31;
            float c2[2];
#pragma unroll
            for (int bj = 0; bj < 2; ++bj) { const int col = bj * DFF + j;
                const float xm2 = t >= 2 ? US[(size_t)(row - 2) * NUP + col] : cprev[(size_t)(b * 2 + t) * NUP + col];
                const float xm1 = t >= 1 ? US[(size_t)(row - 1) * NUP + col] : cprev[(size_t)(b * 2 + 1) * NUP + col];
                const float x0 = US[(size_t)row * NUP + col];
                c2[bj] = cb[col] + cw[col] * xm2 + cw[NUP + col] * xm1 + cw[2 * NUP + col] * x0; }
            ACT[(size_t)(MP + row) * DFF + j] = (bf16_t)cvt_pk_bf16(gelu1(c2[0]) * c2[1], 0.f);
        } else {
            const int r = id - NPF - NSF; const int col = r % NUP, k = (r / NUP) & 1, b = r / (2 * NUP);
            o_sfc[r] = US[(size_t)(b * 32 + 30 + k) * NUP + col];
        }
    }
}

template <int NQB, bool MIXB>
__device__ __forceinline__ void attn_item(bf16_t* Qp, const bf16_t* Kb, const bf16_t* Vb, int kb0, int kb1, int qpos0, float slope_l2, float sink_l2, const LAS float* tbl, int lane) {
    const int r32 = lane & 31, hi = lane >> 5;
    bf16x8 qf[NQB][4];
#pragma unroll
    for (int qb = 0; qb < NQB; ++qb)
#pragma unroll
        for (int d0 = 0; d0 < 4; ++d0) qf[qb][d0] = *(const bf16x8*)(Qp + (size_t)(32 * qb + r32) * DM + 32 * hi + 8 * d0);
    f32x16 o[NQB][2]; float mrun[NQB], lrun[NQB];
#pragma unroll
    for (int qb = 0; qb < NQB; ++qb) { mrun[qb] = -1e30f; lrun[qb] = 0.f;
#pragma unroll
        for (int d = 0; d < 2; ++d)
#pragma unroll
            for (int r = 0; r < 16; ++r) o[qb][d][r] = 0.f; }
    const float SC = 0.125f * LOG2E;
    for (int kb = kb0; kb < kb1; ++kb) {
        const bf16_t* kp = Kb + (size_t)kb * 2048 + hi * 256 + r32 * 8;
        const bf16_t* vp = Vb + (size_t)kb * 2048 + hi * 256 + r32 * 8;
        bf16x8 kf[4], vf[4];
#pragma unroll
        for (int d0 = 0; d0 < 4; ++d0) kf[d0] = *(const bf16x8*)(kp + d0 * 512);
#pragma unroll
        for (int i = 0; i < 4; ++i) vf[i] = *(const bf16x8*)(vp + i * 512);
#pragma unroll
        for (int qb = 0; qb < NQB; ++qb) {
            f32x16 s;
#pragma unroll
            for (int r = 0; r < 16; ++r) s[r] = 0.f;
#pragma unroll
            for (int d0 = 0; d0 < 4; ++d0) s = __builtin_amdgcn_mfma_f32_32x32x16_bf16(kf[d0], qf[qb][d0], s, 0, 0, 0);
            const int dbase = qpos0 + 32 * qb + r32 - kb * 32 - 4 * hi;
            float mx = -1e30f;
#pragma unroll
            for (int r = 0; r < 16; ++r) {
                const int dist = dbase - ((r & 3) + 8 * (r >> 2));
                float bias;
                if (MIXB) { int idx = dist < -128 ? -128 : dist; idx = idx > 128 ? 128 : idx; bias = tbl[idx + 128]; }
                else bias = -slope_l2 * __builtin_fabsf((float)dist);
                s[r] = s[r] * SC + bias; mx = __builtin_fmaxf(mx, s[r]);
            }
            mx = __builtin_fmaxf(mx, __shfl_xor(mx, 32));
            const float mnew = __builtin_fmaxf(mrun[qb], mx), alpha = __builtin_amdgcn_exp2f(mrun[qb] - mnew);
            mrun[qb] = mnew;
            float ls = 0.f;
#pragma unroll
            for (int r = 0; r < 16; ++r) { s[r] = __builtin_amdgcn_exp2f(s[r] - mnew); ls += s[r]; }
            lrun[qb] = lrun[qb] * alpha + ls;
#pragma unroll
            for (int d = 0; d < 2; ++d)
#pragma unroll
                for (int r = 0; r < 16; ++r) o[qb][d][r] *= alpha;
            u32x4 p0, p1;
            p0.x = cvt_pk_bf16(s[0], s[1]); p0.y = cvt_pk_bf16(s[2], s[3]); p0.z = cvt_pk_bf16(s[4], s[5]); p0.w = cvt_pk_bf16(s[6], s[7]);
            p1.x = cvt_pk_bf16(s[8], s[9]); p1.y = cvt_pk_bf16(s[10], s[11]); p1.z = cvt_pk_bf16(s[12], s[13]); p1.w = cvt_pk_bf16(s[14], s[15]);
            const bf16x8 pf0 = __builtin_bit_cast(bf16x8, p0), pf1 = __builtin_bit_cast(bf16x8, p1);
            o[qb][0] = __builtin_amdgcn_mfma_f32_32x32x16_bf16(vf[0], pf0, o[qb][0], 0, 0, 0);
            o[qb][1] = __builtin_amdgcn_mfma_f32_32x32x16_bf16(vf[1], pf0, o[qb][1], 0, 0, 0);
            o[qb][0] = __builtin_amdgcn_mfma_f32_32x32x16_bf16(vf[2], pf1, o[qb][0], 0, 0, 0);
            o[qb][1] = __builtin_amdgcn_mfma_f32_32x32x16_bf16(vf[3], pf1, o[qb][1], 0, 0, 0);
        }
    }
#pragma unroll
    for (int qb = 0; qb < NQB; ++qb) {
        float lt = lrun[qb] + __shfl_xor(lrun[qb], 32);
        if (!MIXB) lt += __builtin_amdgcn_exp2f(sink_l2 - mrun[qb]);
        const float inv = 1.0f / lt;
        bf16_t* op = Qp + (size_t)(32 * qb + r32) * DM + 4 * hi;
#pragma unroll
        for (int d = 0; d < 2; ++d)
#pragma unroll
            for (int g = 0; g < 4; ++g) { u32x2 w; w.x = cvt_pk_bf16(o[qb][d][4 * g] * inv, o[qb][d][4 * g + 1] * inv); w.y = cvt_pk_bf16(o[qb][d][4 * g + 2] * inv, o[qb][d][4 * g + 3] * inv);
                *(u32x2*)(op + 32 * d + 8 * g) = w; }
    }
}
__device__ __forceinline__ void attn_phase(const Params& P, int l, LAS unsigned char* lds, int vcu, int G, int wave_s) {
    int tid_ = phase_tid(wave_s);
    const int tid = tid_, lane = tid & 63, wave = __builtin_amdgcn_readfirstlane(tid >> 6);
    LAS float* tbl = (LAS float*)(lds + wave * 2048);
    unsigned char* ws = P.ws; asm volatile("" : "+s"(ws));
    bf16_t* QA = (bf16_t*)(ws + WS_QA); bf16_t* QB = (bf16_t*)(ws + WS_QB);
    const float* sinks = P.in[14] + l * 16; const float* rel = P.in[15] + (size_t)l * 257 * 16;
    const int gw = vcu * 8 + wave, NGW = G * 8;
    int cur_h = -1;
    for (int id = gw; id < NBATCH * 16 * 64; id += NGW) {
        const int c = id & 63, h = (id >> 6) & 15, b = id >> 10;
        if (h != cur_h) { for (int i = lane; i < 257; i += 64) tbl[i] = rel[i * 16 + h] * LOG2E; cur_h = h; asm volatile("s_waitcnt lgkmcnt(0)" ::: "memory"); }
        const int kb0 = c >= 8 ? 2 * (c - 8) : 0;
        attn_item<2, true>(QB + ((size_t)b * SEQ + c * 64) * DM + h * 64, (const bf16_t*)(ws + WS_KB) + (size_t)(b * 16 + h) * NT32 * 2048, (const bf16_t*)(ws + WS_VB) + (size_t)(b * 16 + h) * NT32 * 2048,
                           kb0, 2 * (c + 1), 64 * c, 0.f, 0.f, tbl, lane);
    }
    for (int id = gw; id < NBATCH * 16 * 64; id += NGW) {
        const int c = id & 63, h = (id >> 6) & 15, b = id >> 10;
        const int kb0 = c >= 2 ? 2 * (c - 2) : 0;
        const float slope = __builtin_amdgcn_exp2f(-0.5f * (float)(h + 1)) * LOG2E;
        attn_item<2, false>(QA + ((size_t)b * SEQ + c * 64) * DM + h * 64, (const bf16_t*)(ws + WS_KA) + (size_t)(b * 4 + (h >> 2)) * NT32 * 2048, (const bf16_t*)(ws + WS_VA) + (size_t)(b * 4 + (h >> 2)) * NT32 * 2048,
                            kb0, 2 * (c + 1), 64 * c, slope, sinks[h] * LOG2E, tbl, lane);
    }
    if (wave == 0) for (int id = vcu; id < 2 * SBATCH * 16; id += G) {
        const int h = id & 15, b = (id >> 4) & 7, mxr = id >> 7;
        if (mxr) {
            if (h != cur_h) { for (int i = lane; i < 257; i += 64) tbl[i] = rel[i * 16 + h] * LOG2E; cur_h = h; asm volatile("s_waitcnt lgkmcnt(0)" ::: "memory"); }
            attn_item<1, true>(QB + ((size_t)MP + b * STOK) * DM + h * 64, (const bf16_t*)(ws + WS_KBS) + (size_t)(b * 16 + h) * NBS_B * 2048, (const bf16_t*)(ws + WS_VBS) + (size_t)(b * 16 + h) * NBS_B * 2048,
                               0, NBS_B, 512, 0.f, 0.f, tbl, lane);
        } else {
            const float slope = __builtin_amdgcn_exp2f(-0.5f * (float)(h + 1)) * LOG2E;
            attn_item<1, false>(QA + ((size_t)MP + b * STOK) * DM + h * 64, (const bf16_t*)(ws + WS_KAS) + (size_t)(b * 4 + (h >> 2)) * NBS_A * 2048, (const bf16_t*)(ws + WS_VAS) + (size_t)(b * 4 + (h >> 2)) * NBS_A * 2048,
                                0, NBS_A, 128, slope, sinks[h] * LOG2E, tbl, lane);
        }
    }
}

constexpr int LDS_BYTES = 135168;
__global__ void __launch_bounds__(512, 2) fwd_megakernel(Params P) {
    extern __shared__ __attribute__((aligned(16))) unsigned char lds_raw[];
    LAS unsigned char* lds = (LAS unsigned char*)lds_raw;
    cg::grid_group grid = cg::this_grid();
    const int G = gridDim.x, bx = blockIdx.x;
    const int wave_s = __builtin_amdgcn_readfirstlane((int)threadIdx.x >> 6);
    const int vcu = (G % 8 == 0) ? (bx % 8) * (G / 8) + bx / 8 : bx;
    unsigned char* ws = P.ws;
    bf16_t* XN = (bf16_t*)(ws + WS_XN);
    float* Y = P.out;

    for (int l = 0; l < DEPTH; ++l) {
#ifndef X_NOPRE
        pre_phase(P, l, lds, vcu, G, l == 0 ? P.in[0] : Y, l == 0 ? P.in[1] : Y + (size_t)MP * DM, wave_s);
#endif
        grid.sync();
        {
            pg8::Gemm g{XN, (const bf16_t*)(ws + WS_WIN), MT, NQKV, DM}; pg8::StaticOrder S; S.init(MT, NQKV, G, bx);
            EpiG1a E{ws, P.out, P.in[10] + l * 64, P.in[11] + l * 64, P.in[12] + l * 64, P.in[13] + l * 64, l};
#ifndef X_NOG1A
            pg8::gemm_phase<EpiG1a>(lds, g, S, E, wave_s);
#endif
        }
        grid.sync();
#ifndef X_NOATT
        attn_phase(P, l, lds, vcu, G, wave_s);
#endif
        grid.sync();
        {
            pg8::Gemm g{XN, (const bf16_t*)(ws + WS_WIN) + (size_t)NQKV * DM, MT, NIN - NQKV, DM}; pg8::StaticOrder S; S.init(MT, NIN - NQKV, G, bx);
            EpiG1b E{(bf16_t*)(ws + WS_QA), (const bf16_t*)(ws + WS_QB), P.in[9] + (size_t)l * 2 * DM};
#ifndef X_NOG1B
            pg8::gemm_phase<EpiG1b>(lds, g, S, E, wave_s);
#endif
        }
        grid.sync();
        {
            pg8::Gemm g{(const bf16_t*)(ws + WS_QA), (const bf16_t*)(ws + WS_WOUT), MT, DM, DM}; pg8::StaticOrder S; S.init(MT, DM, G, bx);
            EpiRes E{l == 0 ? P.in[0] : Y, l == 0 ? P.in[1] : Y + (size_t)MP * DM, Y, 1.0f, 1.0f};
            pg8::gemm_phase<EpiRes>(lds, g, S, E, wave_s);
        }
        grid.sync();
        norm2_phase(P, l, vcu, G, wave_s);
        grid.sync();
        {
            pg8::Gemm g{XN, (const bf16_t*)(ws + WS_WUP), MT, NUP, DM}; pg8::StaticOrder S; S.init(MT, NUP, G, bx);
            EpiG3 E{ws, P.out + O_PFC + (size_t)l * NBATCH * 2 * NUP, P.in[19] + (size_t)l * 3 * NUP, P.in[20] + (size_t)l * NUP};
#ifndef X_NOG3
            pg8::gemm_phase<EpiG3>(lds, g, S, E, wave_s);
#endif
        }
        grid.sync();
#ifndef X_NOFIX
        fix_phase(P, l, vcu, G, wave_s);
#endif
        grid.sync();
        {
            pg8::Gemm g{(const bf16_t*)(ws + WS_ACT), (const bf16_t*)(ws + WS_WDN), MT, DM, DFF}; pg8::StaticOrder S; S.init(MT, DM, G, bx);
            #ifdef DBG_NOFFN
            EpiRes E{Y, Y + (size_t)MP * DM, Y, 0.0f, 1.0f};
#else
#ifdef DBG_SCALEY
            EpiRes E{Y, Y + (size_t)MP * DM, Y, 1.0f, l == 1 ? 0.8f : 1.0f};
#else
            EpiRes E{Y, Y + (size_t)MP * DM, Y, 1.0f, 1.0f};
#endif
#endif
            pg8::gemm_phase<EpiRes>(lds, g, S, E, wave_s);
        }
        if (l + 1 < DEPTH) grid.sync();
    }
}

extern "C" void kernel_launch(void* const* d_in, const int* in_sizes, int n_in, void* d_out, int out_size, void* d_ws, size_t ws_size, hipStream_t stream) {
    static int grid_blocks = 0;
    if (grid_blocks == 0) {
        if (n_in != 22 || (size_t)out_size != O_END || ws_size < WS_END) { fprintf(stderr, "kernel_launch: unexpected shapes: n_in %d out %d ws %zu\n", n_in, out_size, ws_size); grid_blocks = -1; return; }
        int dev = 0, cus = 0, per_cu = 0;
        hipGetDevice(&dev); hipDeviceGetAttribute(&cus, hipDeviceAttributeMultiprocessorCount, dev);
        hipFuncSetAttribute((const void*)fwd_megakernel, hipFuncAttributeMaxDynamicSharedMemorySize, LDS_BYTES);
        hipOccupancyMaxActiveBlocksPerMultiprocessor(&per_cu, (const void*)fwd_megakernel, 512, LDS_BYTES);
        if (per_cu < 1) { fprintf(stderr, "kernel_launch: occupancy query says %d blocks/CU\n", per_cu); per_cu = 1; }
        (void)hipGetLastError();
        grid_blocks = cus;
    }
    if (grid_blocks < 0) return;
    Params p{};
    for (int i = 0; i < 22; ++i) p.in[i] = (const float*)d_in[i];
    p.out = (float*)d_out; p.ws = (unsigned char*)d_ws;
    void* args[] = {&p};
    hipError_t e = hipLaunchCooperativeKernel((const void*)fwd_megakernel, dim3(grid_blocks), dim3(512), args, LDS_BYTES, stream);
    if (e != hipSuccess) fprintf(stderr, "cooperative launch failed: %s (grid %d)\n", hipGetErrorString(e), grid_blocks);
}
```

```cpp
#include <hip/hip_runtime.h>
#include <hip/hip_cooperative_groups.h>
#include <cstdio>
#include <cstdint>
namespace cg = cooperative_groups;

#define LAS __attribute__((address_space(3)))
typedef unsigned short bf16_t;
typedef short bf16x8 __attribute__((ext_vector_type(8)));
typedef float f32x4 __attribute__((ext_vector_type(4)));
typedef float f32x2 __attribute__((ext_vector_type(2)));
typedef float f32x16 __attribute__((ext_vector_type(16)));
typedef unsigned u32x4 __attribute__((ext_vector_type(4)));
typedef unsigned u32x2 __attribute__((ext_vector_type(2)));
typedef __bf16 bf16x2_t __attribute__((ext_vector_type(2)));

constexpr int DM = 1024, MP = 16384, MS = 256, MT = MP + MS, SEQ = 4096, NBATCH = 4, SBATCH = 8, STOK = 32;
constexpr int NIN = 6656, NQKV = 4608, DFF = 2816, NUP = 5632, DEPTH = 2;
constexpr int NT32 = SEQ / 32;
constexpr int NBS_A = 5, NBS_B = 17;
constexpr float EPS = 1e-6f, LOG2E = 1.4426950408889634f;

constexpr size_t O_YP = 0, O_YS = 16777216, O_PAK = 17039360, O_PAV = 17301504, O_PBK = 17563648, O_PBV = 21757952,
                 O_PFC = 25952256, O_SAK = 26042368, O_SAV = 26173440, O_SBK = 26304512, O_SBV = 26828800, O_SFC = 27353088,
                 O_END = 27533312;
constexpr size_t MiB = 1u << 20;
constexpr size_t WS_WIN = 1 * MiB, WS_WOUT = 14 * MiB, WS_WUP = 16 * MiB, WS_WDN = 27 * MiB, WS_XN = 33 * MiB, WS_QA = 66 * MiB, WS_QB = 99 * MiB,
                 WS_KA = 132 * MiB, WS_VA = 140 * MiB, WS_KB = 148 * MiB, WS_VB = 180 * MiB, WS_KAS = 212 * MiB, WS_VAS = 213 * MiB,
                 WS_KBS = 214 * MiB, WS_VBS = 223 * MiB, WS_ACT = 66 * MiB, WS_HU = 156 * MiB, WS_US = 178 * MiB, WS_GS = 232 * MiB, WS_PART = 233 * MiB, WS_END = 245 * MiB;

struct Params { const float* in[22]; float* out; unsigned char* ws; };

__device__ __forceinline__ unsigned cvt_pk_bf16(float lo, float hi) { f32x2 v = {lo, hi}; bf16x2_t b = __builtin_convertvector(v, bf16x2_t); return __builtin_bit_cast(unsigned, b); }
__device__ __forceinline__ float bf2f(unsigned short b) { return __builtin_bit_cast(float, (unsigned)b << 16); }

__device__ __forceinline__ int phase_tid(int wave_s) { int lane; asm volatile("v_mbcnt_lo_u32_b32 %0, -1, 0\n\tv_mbcnt_hi_u32_b32 %0, -1, %0" : "=v"(lane)); return wave_s * 64 + lane; }
namespace pg8 {
constexpr int BM = 256, BK = 64, HALF = 128, HTB = HALF * BK * 2, STAGE_BYTES = 8 * HTB, NXCD = 8, WGM = 2;
__host__ __device__ __forceinline__ int lds_byte(int r, int c) { const int st = (r >> 4) * 2 + (c >> 5), rr = r & 15, cc = c & 31, ob = rr * 64 + cc * 2; return st * 1024 + (ob ^ (((ob >> 9) & 1) << 5)); }
__host__ __device__ __forceinline__ void stage_rc(int b, int& R, int& C) { const int st = b / 1024, sb = b % 1024, swz = sb ^ (((sb >> 9) & 1) << 5); R = (st >> 1) * 16 + swz / 64; C = (st & 1) * 32 + (swz % 64) / 2; }
__host__ __device__ __forceinline__ int perm32(int rho) { const int n = rho >> 4, i = rho & 15; return 8 * (i >> 2) + 4 * n + (i & 3); }

struct Unit { int pm, pn, k0, nt; };
struct Gemm { const bf16_t* A; const bf16_t* Bt; int M, N, K; };

struct StaticOrder {
    int nNp, nP, nNs, nS, ntp, nts, G, c;
    __device__ void init(int nNp_, int nNs_, int nsplit, int ntfull, int G_, int c_) { nNp = nNp_; nP = 64 * nNp_; nNs = nNs_; nS = nNs_ * nsplit; ntp = ntfull; nts = ntfull / nsplit; G = G_; c = c_; }
    __device__ bool next(int i, Unit& u) const {
        const int L = i * G + c; if (L >= nP + nS) return false;
        if (L >= nP) { const int sI = L - nP; u.pm = 64; u.pn = sI % nNs; u.k0 = (sI / nNs) * nts; u.nt = nts; return true; }
        int wgid = L; { const int q = nP / NXCD, xcd = wgid % NXCD, off = wgid / NXCD; wgid = xcd * q + off; }
        const int nig = WGM * nNp, gid = wgid / nig, fm = gid * WGM;
        u.pm = fm + ((wgid % nig) % WGM); u.pn = (wgid % nig) / WGM; u.k0 = 0; u.nt = ntp; return true;
    }
};

template <class Epi>
__device__ __forceinline__ void gemm_phase(LAS unsigned char* lds, Gemm g, const StaticOrder& S, const Epi& E, int wave_s) {
    int tid_ = phase_tid(wave_s);
    asm volatile("" : "+s"(g.A), "+s"(g.Bt));
    const int tid = tid_, wid = __builtin_amdgcn_readfirstlane(tid >> 6), lane = tid & 63, wr = wid >> 2, wc = wid & 3, fr = lane & 15, fq = lane >> 4;
    const int K = g.K;
    unsigned voffA[2], voffB[2];
#pragma unroll
    for (int i = 0; i < 2; ++i) { int R, C; stage_rc(tid * 16 + i * 8192, R, C); const int Rb = (R & ~31) + perm32(R & 31);
        const int Ra = Epi::APERM ? ((R & ~63) + 4 * (R & 15) + ((R >> 4) & 3)) : R;
        voffA[i] = (unsigned)(Ra * K + C) * 2u; voffB[i] = (unsigned)(Rb * K + C) * 2u; }
    const size_t kstep = (size_t)(BK * 2);
    const size_t hstep = (size_t)HALF * K * 2;
    const size_t tstep = 2 * hstep;
    const unsigned ldsw = (unsigned)wid * 1024u;
    const int aoff = lds_byte(wr * 64 + fr, fq * 8), boff = lds_byte(wc * 32 + fr, fq * 8);
#define PG8_SA(b, h) (((b) * 2 + (h)) * HTB)
#define PG8_SB(b, h) ((4 + (b) * 2 + (h)) * HTB)
#define PG8_STAGE(bufoff, gbase, voff) do { _Pragma("unroll") for (int _i = 0; _i < 2; ++_i) \
        __builtin_amdgcn_global_load_lds((const unsigned*)((const char*)(gbase) + (voff)[_i]), (LAS unsigned*)(lds + (bufoff) + ldsw + _i * 8192), 16, 0, 0); } while (0)
#define PG8_LDA(dst, b, h) do { _Pragma("unroll") for (int m = 0; m < 4; ++m) _Pragma("unroll") for (int k = 0; k < 2; ++k) dst[m][k] = *(const LAS bf16x8*)(lds + PG8_SA(b, h) + aoff + m * 2048 + k * 1024); } while (0)
#define PG8_LDB(dst, b, h) do { _Pragma("unroll") for (int n = 0; n < 2; ++n) _Pragma("unroll") for (int k = 0; k < 2; ++k) dst[n][k] = *(const LAS bf16x8*)(lds + PG8_SB(b, h) + boff + n * 2048 + k * 1024); } while (0)
#define PG8_MMA(ai, bj, At, Bt) do { __builtin_amdgcn_s_setprio(1); _Pragma("unroll") for (int m = 0; m < 4; ++m) _Pragma("unroll") for (int n = 0; n < 2; ++n) _Pragma("unroll") for (int k = 0; k < 2; ++k) \
        acc[ai][bj][m][n] = __builtin_amdgcn_mfma_f32_16x16x32_bf16(Bt[n][k], At[m][k], acc[ai][bj][m][n], 0, 0, 0); __builtin_amdgcn_s_setprio(0); } while (0)
#define PG8_WAIT_V(n) asm volatile("s_waitcnt vmcnt(" #n ")" ::: "memory")
#define PG8_WAIT_L(n) asm volatile("s_waitcnt lgkmcnt(" #n ")" ::: "memory")
#define PG8_BAR __builtin_amdgcn_s_barrier()
#define PG8_SCHED __builtin_amdgcn_sched_barrier(0)
    Unit cur, nxt; int ui = 0;
    if (!S.next(0, cur)) return;
    f32x4 acc[2][2][4][2];
#pragma unroll
    for (int a = 0; a < 2; ++a)
#pragma unroll
        for (int b = 0; b < 2; ++b)
#pragma unroll
            for (int m = 0; m < 4; ++m)
#pragma unroll
                for (int n = 0; n < 2; ++n) acc[a][b][m][n] = (f32x4){0.f, 0.f, 0.f, 0.f};
    bf16x8 At[4][2], B0[2][2], B1[2][2];
    const char* cA = (const char*)g.A + (size_t)cur.pm * tstep + (size_t)cur.k0 * kstep; const char* cB = (const char*)g.Bt + (size_t)cur.pn * tstep + (size_t)cur.k0 * kstep;
    PG8_STAGE(PG8_SB(0, 0), cB, voffB); PG8_STAGE(PG8_SB(0, 1), cB + hstep, voffB); PG8_STAGE(PG8_SA(0, 0), cA, voffA); PG8_STAGE(PG8_SA(0, 1), cA + hstep, voffA);
    if (wr == 1) PG8_BAR;
    PG8_WAIT_V(2); PG8_BAR;
    PG8_STAGE(PG8_SB(1, 0), cB + kstep, voffB); PG8_STAGE(PG8_SA(1, 0), cA + kstep, voffA); PG8_STAGE(PG8_SB(1, 1), cB + hstep + kstep, voffB);
    PG8_WAIT_V(6); PG8_BAR;
    for (;;) {
        const bool has_next = S.next(ui + 1, nxt);
        const char* nA = has_next ? (const char*)g.A + (size_t)nxt.pm * tstep + (size_t)nxt.k0 * kstep : cA; const char* nB = has_next ? (const char*)g.Bt + (size_t)nxt.pn * tstep + (size_t)nxt.k0 * kstep : cB;
        const int nt = cur.nt;
        for (int t = 0; t < nt; t += 2) {
            const bool last = (t == nt - 2);
            const char* a1 = cA + (size_t)(t + 1) * kstep;
            const char* a2 = last ? nA : cA + (size_t)(t + 2) * kstep; const char* b2 = last ? nB : cB + (size_t)(t + 2) * kstep;
            const char* a3 = a2 + kstep; const char* b3 = b2 + kstep;
            PG8_LDB(B0, 0, 0); PG8_LDB(B1, 0, 1); PG8_SCHED; PG8_LDA(At, 0, 0); PG8_STAGE(PG8_SA(1, 1), a1 + hstep, voffA);
            PG8_WAIT_V(8); PG8_WAIT_L(0); PG8_BAR; PG8_MMA(0, 0, At, B0); PG8_MMA(0, 1, At, B1); PG8_BAR; PG8_SCHED;
            PG8_LDA(At, 0, 1); PG8_STAGE(PG8_SB(0, 0), b2, voffB); PG8_STAGE(PG8_SB(0, 1), b2 + hstep, voffB); PG8_STAGE(PG8_SA(0, 0), a2, voffA);
            PG8_WAIT_V(8); PG8_WAIT_L(0); PG8_BAR; PG8_MMA(1, 0, At, B0); PG8_MMA(1, 1, At, B1); PG8_BAR; PG8_SCHED;
            PG8_LDB(B0, 1, 0); PG8_LDB(B1, 1, 1); PG8_SCHED; PG8_LDA(At, 1, 0); PG8_STAGE(PG8_SA(0, 1), a2 + hstep, voffA);
            PG8_WAIT_V(8); PG8_WAIT_L(0); PG8_BAR; PG8_MMA(0, 0, At, B0); PG8_MMA(0, 1, At, B1); PG8_BAR; PG8_SCHED;
            PG8_LDA(At, 1, 1); PG8_STAGE(PG8_SB(1, 0), b3, voffB); PG8_STAGE(PG8_SB(1, 1), b3 + hstep, voffB); PG8_STAGE(PG8_SA(1, 0), a3, voffA);
            PG8_WAIT_V(8); PG8_WAIT_L(0); PG8_BAR; PG8_MMA(1, 0, At, B0); PG8_MMA(1, 1, At, B1); PG8_BAR; PG8_SCHED;
        }
        if (wr == 0) PG8_BAR;
        E(acc, cur, wr, wc, fr, fq);
        if (!has_next) break;
#pragma unroll
        for (int a = 0; a < 2; ++a)
#pragma unroll
            for (int b = 0; b < 2; ++b)
#pragma unroll
                for (int m = 0; m < 4; ++m)
#pragma unroll
                    for (int n = 0; n < 2; ++n) acc[a][b][m][n] = (f32x4){0.f, 0.f, 0.f, 0.f};
        cur = nxt; cA = nA; cB = nB; ++ui;
        if (wr == 1) PG8_BAR;
    }
    PG8_WAIT_V(0);
    PG8_BAR;
#undef PG8_SA
#undef PG8_SB
#undef PG8_STAGE
#undef PG8_LDA
#undef PG8_LDB
#undef PG8_MMA
#undef PG8_WAIT_V
#undef PG8_WAIT_L
#undef PG8_BAR
#undef PG8_SCHED
}
}
using pg8::Unit;
typedef const f32x4 (&AccRef)[2][2][4][2];

__device__ __forceinline__ float gelu1(float v) {
    const float av = __builtin_fabsf(v), d = av * 0.2316418882f + 1.0f;
    const float t = __builtin_amdgcn_rcpf(d);
    float q = t * 0.5307027145f + (-0.7265760135f); q = q * t + 0.7107068705f; q = q * t + (-0.142248368f); q = q * t + 0.127414796f; q = q * t;
    const float e = __builtin_amdgcn_exp2f((v * v) * (-0.72134752044f));
    const float m = v * (q * e), r = v - m;
    return v < 0.f ? m : r;
}
__device__ __forceinline__ float sigmoidf_(float x) { return __builtin_amdgcn_rcpf(1.0f + __builtin_amdgcn_exp2f(-x * LOG2E)); }

struct EpiG1a {
    static constexpr bool APERM = false;
    unsigned char* ws; float* out; const float *gqa, *gka, *gqb, *gkb; const float* bg; int l;
    __device__ __forceinline__ void operator()(AccRef acc, const Unit& u, int wr, int wc, int fr, int fq) const {
        asm volatile("" : "+v"(fr), "+v"(fq));
        const int pn = u.pn; const bool samp = (u.pm == 64);
        if (pn >= 18) {
            bf16_t* GS = (bf16_t*)(ws + WS_GS); const int c0 = (pn - 18) * 128 + wc * 32 + 8 * fq;
#pragma unroll
            for (int bj = 0; bj < 2; ++bj) {
                const f32x4 b0 = *(const f32x4*)(bg + bj * DM + c0), b1 = *(const f32x4*)(bg + bj * DM + c0 + 4);
#pragma unroll
                for (int ai = 0; ai < 2; ++ai)
#pragma unroll
                    for (int m = 0; m < 4; ++m) {
                        const f32x4 a = acc[ai][bj][m][0] + b0, c = acc[ai][bj][m][1] + b1;
                        u32x4 w; w.x = cvt_pk_bf16(sigmoidf_(a[0]), sigmoidf_(a[1])); w.y = cvt_pk_bf16(sigmoidf_(a[2]), sigmoidf_(a[3])); w.z = cvt_pk_bf16(sigmoidf_(c[0]), sigmoidf_(c[1])); w.w = cvt_pk_bf16(sigmoidf_(c[2]), sigmoidf_(c[3]));
                        *(u32x4*)(GS + (size_t)(ai * 128 + wr * 64 + m * 16 + fr) * 2048 + bj * DM + c0) = w;
                    }
            }
            return;
        }
        int ty, hs, mb;
        if (pn < 4) { ty = 0; mb = 0; hs = pn * 4 + wc; } else if (pn == 4) { ty = 1; mb = 0; hs = wc; } else if (pn == 5) { ty = 2; mb = 0; hs = wc; }
        else if (pn < 10) { ty = 0; mb = 1; hs = (pn - 6) * 4 + wc; } else if (pn < 14) { ty = 1; mb = 1; hs = (pn - 10) * 4 + wc; } else { ty = 2; mb = 1; hs = (pn - 14) * 4 + wc; }
        if (ty == 0) {
            bf16_t* Q = (bf16_t*)(ws + (mb ? WS_QB : WS_QA)); const float* gg = mb ? gqb : gqa;
            f32x4 gv[2][2];
#pragma unroll
            for (int bj = 0; bj < 2; ++bj)
#pragma unroll
                for (int n = 0; n < 2; ++n) gv[bj][n] = *(const f32x4*)(gg + 32 * bj + 8 * fq + 4 * n);
#pragma unroll
            for (int ai = 0; ai < 2; ++ai)
#pragma unroll
                for (int m = 0; m < 4; ++m) {
                    float ss = 0.f;
#pragma unroll
                    for (int bj = 0; bj < 2; ++bj)
#pragma unroll
                        for (int n = 0; n < 2; ++n) { const f32x4 x = acc[ai][bj][m][n]; ss += (x[0] * x[0] + x[1] * x[1]) + (x[2] * x[2] + x[3] * x[3]); }
                    ss += __shfl_xor(ss, 16); ss += __shfl_xor(ss, 32);
                    const float rs = __builtin_amdgcn_rsqf(ss * (1.0f / 64.0f) + EPS);
                    const size_t row = (size_t)u.pm * 256 + ai * 128 + wr * 64 + m * 16 + fr;
                    bf16_t* qp = Q + row * DM + hs * 64 + 8 * fq;
#pragma unroll
                    for (int bj = 0; bj < 2; ++bj) {
                        const f32x4 a = acc[ai][bj][m][0] * rs * gv[bj][0], b = acc[ai][bj][m][1] * rs * gv[bj][1];
                        u32x4 w; w.x = cvt_pk_bf16(a[0], a[1]); w.y = cvt_pk_bf16(a[2], a[3]); w.z = cvt_pk_bf16(b[0], b[1]); w.w = cvt_pk_bf16(b[2], b[3]);
                        *(u32x4*)(qp + 32 * bj) = w;
                    }
                }
            return;
        }
        const int H = mb ? 16 : 4, W = mb ? 512 : 128, NBS = mb ? NBS_B : NBS_A;
        bf16_t* KVp = (bf16_t*)(ws + ((ty == 1) ? (mb ? WS_KB : WS_KA) : (mb ? WS_VB : WS_VA)));
        bf16_t* KVs = (bf16_t*)(ws + ((ty == 1) ? (mb ? WS_KBS : WS_KAS) : (mb ? WS_VBS : WS_VAS)));
        float* op = out + ((ty == 1) ? (mb ? O_PBK : O_PAK) : (mb ? O_PBV : O_PAV)) + (size_t)l * NBATCH * W * H * 64;
        float* os = out + ((ty == 1) ? (mb ? O_SBK : O_SAK) : (mb ? O_SBV : O_SAV)) + (size_t)l * SBATCH * STOK * H * 64;
        f32x4 gv[2][2];
#pragma unroll
        for (int bj = 0; bj < 2; ++bj)
#pragma unroll
            for (int n = 0; n < 2; ++n) gv[bj][n] = (ty == 1) ? *(const f32x4*)((mb ? gkb : gka) + 32 * bj + 8 * fq + 4 * n) : (f32x4){1.f, 1.f, 1.f, 1.f};
#pragma unroll
        for (int ai = 0; ai < 2; ++ai)
#pragma unroll
            for (int m = 0; m < 4; ++m) {
                float rs = 1.0f;
                if (ty == 1) {
                    float ss = 0.f;
#pragma unroll
                    for (int bj = 0; bj < 2; ++bj)
#pragma unroll
                        for (int n = 0; n < 2; ++n) { const f32x4 x = acc[ai][bj][m][n]; ss += (x[0] * x[0] + x[1] * x[1]) + (x[2] * x[2] + x[3] * x[3]); }
                    ss += __shfl_xor(ss, 16); ss += __shfl_xor(ss, 32);
                    rs = __builtin_amdgcn_rsqf(ss * (1.0f / 64.0f) + EPS);
                }
                const int rloc = ai * 128 + wr * 64 + m * 16 + fr;
                int b, t, kidx; bf16_t* blk; float* fo = nullptr;
                if (!samp) { b = u.pm >> 4; t = (u.pm & 15) * 256 + rloc; kidx = t; blk = KVp + ((size_t)(b * H + hs) * NT32 + (t >> 5)) * 2048;
                    if (t >= SEQ - W) fo = op + ((size_t)(b * W + (t - (SEQ - W))) * H + hs) * 64; }
                else { b = rloc >> 5; t = rloc & 31; kidx = W + t; blk = KVs + ((size_t)(b * H + hs) * NBS + (kidx >> 5)) * 2048;
                    fo = os + ((size_t)(b * STOK + t) * H + hs) * 64; }
                const int tt = kidx & 31;
#pragma unroll
                for (int bj = 0; bj < 2; ++bj) {
                    const f32x4 a = acc[ai][bj][m][0] * rs * gv[bj][0], c = acc[ai][bj][m][1] * rs * gv[bj][1];
                    if (fo) { *(f32x4*)(fo + 32 * bj + 8 * fq) = a; *(f32x4*)(fo + 32 * bj + 8 * fq + 4) = c; }
                    if (ty == 1) {
                        u32x4 w; w.x = cvt_pk_bf16(a[0], a[1]); w.y = cvt_pk_bf16(a[2], a[3]); w.z = cvt_pk_bf16(c[0], c[1]); w.w = cvt_pk_bf16(c[2], c[3]);
                        *(u32x4*)(blk + ((fq * 2 + bj) * 32 + tt) * 8) = w;
                    } else {
                        const int s = tt >> 4, u16 = tt & 15, hi = (u16 >> 2) & 1, j = (u16 & 3) + 4 * (u16 >> 3);
                        bf16_t* vp = blk + (((s * 2 + bj) * 2 + hi) * 32 + 8 * fq) * 8 + j;
                        const unsigned p0 = cvt_pk_bf16(a[0], a[1]), p1 = cvt_pk_bf16(a[2], a[3]), p2 = cvt_pk_bf16(c[0], c[1]), p3 = cvt_pk_bf16(c[2], c[3]);
                        vp[0] = (bf16_t)p0; vp[8] = (bf16_t)(p0 >> 16); vp[16] = (bf16_t)p1; vp[24] = (bf16_t)(p1 >> 16);
                        vp[32] = (bf16_t)p2; vp[40] = (bf16_t)(p2 >> 16); vp[48] = (bf16_t)p3; vp[56] = (bf16_t)(p3 >> 16);
                    }
                }
                asm volatile("" ::: "memory");
            }
    }
};
struct EpiG1b {
    static constexpr bool APERM = false;
    bf16_t *OA; const bf16_t* OB; const float* bg;
    __device__ __forceinline__ void operator()(AccRef acc, const Unit& u, int wr, int wc, int fr, int fq) const {
        asm volatile("" : "+v"(fr), "+v"(fq));
        const int c0 = u.pn * 128 + wc * 32 + 8 * fq;
        f32x4 ba[2], bb[2];
#pragma unroll
        for (int n = 0; n < 2; ++n) { ba[n] = *(const f32x4*)(bg + c0 + 4 * n); bb[n] = *(const f32x4*)(bg + DM + c0 + 4 * n); }
#pragma unroll
        for (int ai = 0; ai < 2; ++ai)
#pragma unroll
            for (int m = 0; m < 4; ++m) {
                const size_t off = ((size_t)u.pm * 256 + ai * 128 + wr * 64 + m * 16 + fr) * DM + c0;
                const u32x4 oa = *(const u32x4*)(OA + off), ob = *(const u32x4*)(OB + off);
                float r[8];
#pragma unroll
                for (int n = 0; n < 2; ++n)
#pragma unroll
                    for (int e = 0; e < 4; ++e) {
                        const int j = 4 * n + e; const unsigned wa = oa[j >> 1], wb = ob[j >> 1];
                        const float fa = (j & 1) ? __builtin_bit_cast(float, wa & 0xffff0000u) : __builtin_bit_cast(float, wa << 16);
                        const float fb = (j & 1) ? __builtin_bit_cast(float, wb & 0xffff0000u) : __builtin_bit_cast(float, wb << 16);
                                r[j] = sigmoidf_(acc[ai][0][m][n][e] + ba[n][e]) * fa + sigmoidf_(acc[ai][1][m][n][e] + bb[n][e]) * fb;
                    }
                u32x4 w; w.x = cvt_pk_bf16(r[0], r[1]); w.y = cvt_pk_bf16(r[2], r[3]); w.z = cvt_pk_bf16(r[4], r[5]); w.w = cvt_pk_bf16(r[6], r[7]);
                *(u32x4*)(OA + off) = w;
                asm volatile("" ::: "memory");
            }
    }
};
struct EpiRes {
    static constexpr bool APERM = false;
    const float* xin_p; float* xout; float* part;
    __device__ __forceinline__ void operator()(AccRef acc, const Unit& u, int wr, int wc, int fr, int fq) const {
        asm volatile("" : "+v"(fr), "+v"(fq));
        float* ob = xout + (size_t)u.pm * 256 * DM;
        if (u.pm == 64) {
            float* pb = part + (size_t)(u.k0 / u.nt) * MS * DM;
#pragma unroll
            for (int ai = 0; ai < 2; ++ai)
#pragma unroll
                for (int m = 0; m < 4; ++m) {
                    const size_t off = (size_t)(ai * 128 + wr * 64 + m * 16 + fr) * DM + u.pn * 256 + wc * 32 + 8 * fq;
#pragma unroll
                    for (int bj = 0; bj < 2; ++bj)
#pragma unroll
                        for (int n = 0; n < 2; ++n) *(f32x4*)(pb + off + bj * 128 + 4 * n) = acc[ai][bj][m][n];
                }
            return;
        }
        const float* xb = xin_p + (size_t)u.pm * 256 * DM;
#pragma unroll
        for (int ai = 0; ai < 2; ++ai)
#pragma unroll
            for (int m = 0; m < 4; ++m) {
                const size_t off = (size_t)(ai * 128 + wr * 64 + m * 16 + fr) * DM + u.pn * 256 + wc * 32 + 8 * fq;
#pragma unroll
                for (int bj = 0; bj < 2; ++bj)
#pragma unroll
                    for (int n = 0; n < 2; ++n) { const f32x4 x = *(const f32x4*)(xb + off + bj * 128 + 4 * n); *(f32x4*)(ob + off + bj * 128 + 4 * n) = x + acc[ai][bj][m][n]; }
                asm volatile("" ::: "memory");
            }
    }
};
__device__ __forceinline__ float dpp_shr1(float x) { return __builtin_bit_cast(float, __builtin_amdgcn_update_dpp(0, __builtin_bit_cast(int, x), 0x111  , 0xf, 0xf, false)); }
__device__ __forceinline__ f32x4 dpp_prev_lane(f32x4 v) {
    const float a = dpp_shr1(v.x), b = dpp_shr1(v.y), c = dpp_shr1(v.z), d = dpp_shr1(v.w);
    return (f32x4){a, b, c, d};
}
struct EpiG3 {
    static constexpr bool APERM = true;
    unsigned char* ws; float* o_pfc; const float* cw; const float* cb;
    __device__ __forceinline__ void operator()(AccRef acc, const Unit& u, int wr, int wc, int fr, int fq) const {
        asm volatile("" : "+v"(fr), "+v"(fq));
        bf16_t* ACT = (bf16_t*)(ws + WS_ACT); float* HU = (float*)(ws + WS_HU); float* US = (float*)(ws + WS_US);
        const int ca0 = u.pn * 128 + wc * 32 + 8 * fq;
        if (u.pm == 64) {
#pragma unroll
            for (int ai = 0; ai < 2; ++ai)
#pragma unroll
                for (int m = 0; m < 4; ++m) { float* p = US + (size_t)(ai * 128 + wr * 64 + 4 * fr + m) * NUP + ca0;
#pragma unroll
                    for (int bj = 0; bj < 2; ++bj)
#pragma unroll
                        for (int n = 0; n < 2; ++n) *(f32x4*)(p + bj * DFF + 4 * n) = acc[ai][bj][m][n]; }
            return;
        }
#pragma unroll
        for (int ai = 0; ai < 2; ++ai) {
            const int seg = u.pm * 4 + ai * 2 + wr;
            const size_t row0 = (size_t)u.pm * 256 + ai * 128 + wr * 64 + 4 * fr;
            const bool lastseg = ((u.pm & 15) == 15) && ai == 1 && wr == 1;
#pragma unroll
            for (int n = 0; n < 2; ++n) {
                f32x4 cg[4];
#pragma unroll
                for (int bj = 1; bj >= 0; --bj) {
                    const int col = bj * DFF + ca0 + 4 * n;
                    const f32x4 w0 = *(const f32x4*)(cw + col), w1 = *(const f32x4*)(cw + NUP + col), w2 = *(const f32x4*)(cw + 2 * NUP + col), bb = *(const f32x4*)(cb + col);
                    const f32x4 x0 = acc[ai][bj][0][n], x1 = acc[ai][bj][1][n], x2 = acc[ai][bj][2][n], x3 = acc[ai][bj][3][n];
                    const f32x4 p1 = dpp_prev_lane(x3), p2 = dpp_prev_lane(x2);
                    if (fr == 0) { float* h = HU + (size_t)seg * 4 * NUP + col; *(f32x4*)h = x0; *(f32x4*)(h + NUP) = x1; }
                    if (fr == 15) { float* h = HU + (size_t)seg * 4 * NUP + 2 * NUP + col; *(f32x4*)h = x2; *(f32x4*)(h + NUP) = x3;
                        if (lastseg) { float* o = o_pfc + (size_t)(u.pm >> 4) * 2 * NUP + col; *(f32x4*)o = x2; *(f32x4*)(o + NUP) = x3; } }
                    f32x4 c[4];
                    c[0] = bb + w0 * p2 + w1 * p1 + w2 * x0;
                    c[1] = bb + w0 * p1 + w1 * x0 + w2 * x1;
                    c[2] = bb + w0 * x0 + w1 * x1 + w2 * x2;
                    c[3] = bb + w0 * x1 + w1 * x2 + w2 * x3;
                    if (bj == 1) {
#pragma unroll
                        for (int m = 0; m < 4; ++m) cg[m] = c[m];
                    } else {
#pragma unroll
                        for (int m = 0; m < 4; ++m) {
                            const float a0 = gelu1(c[m][0]) * cg[m][0], a1 = gelu1(c[m][1]) * cg[m][1], a2 = gelu1(c[m][2]) * cg[m][2], a3 = gelu1(c[m][3]) * cg[m][3];
                            u32x2 w; w.x = cvt_pk_bf16(a0, a1); w.y = cvt_pk_bf16(a2, a3);
                            *(u32x2*)(ACT + (row0 + m) * DFF + ca0 + 4 * n) = w;
                        }
                    }
                }
                asm volatile("" ::: "memory");
            }
        }
    }
};

__device__ __forceinline__ float wave_sum(float v) {
#pragma unroll
    for (int o = 1; o < 64; o <<= 1) v += __shfl_xor(v, o);
    return v;
}
__device__ __forceinline__ void transpose_item(const float* W, int K, int Nsrc, bf16_t* WT, int kb, int nb, int sb, LAS float* scr, int lane) {
    const int k0 = 64 * kb, n0 = 32 * nb, s0 = 32 * sb;
#pragma unroll 8
    for (int i = 0; i < 32; ++i) { const int kk = 2 * i + (lane >> 5); scr[kk * 33 + (lane & 31)] = W[(size_t)(k0 + kk) * Nsrc + s0 + (lane & 31)]; }
    asm volatile("s_waitcnt lgkmcnt(0)" ::: "memory");
    const int c = lane & 7;
#pragma unroll
    for (int j = 0; j < 4; ++j) { const int n = (lane >> 3) + 8 * j; const LAS float* s = scr + (8 * c) * 33 + n;
        u32x4 o; o.x = cvt_pk_bf16(s[0 * 33], s[1 * 33]); o.y = cvt_pk_bf16(s[2 * 33], s[3 * 33]); o.z = cvt_pk_bf16(s[4 * 33], s[5 * 33]); o.w = cvt_pk_bf16(s[6 * 33], s[7 * 33]);
        *(u32x4*)(WT + (size_t)(n0 + n) * K + k0 + 8 * c) = o; }
    asm volatile("s_waitcnt lgkmcnt(0)" ::: "memory");
}
__device__ __forceinline__ int win_srcblk(int nb) {
    const int pn = nb >> 3, sb = nb & 7, bj = sb >> 2, wc = sb & 3;
    if (pn < 18) return 8 * pn + 2 * wc + bj;
    return 144 + 32 * bj + 4 * (pn - 18) + wc;
}
__device__ __forceinline__ int wup_srcblk(int nb) { const int pn = nb >> 3, sb = nb & 7, bj = sb >> 2; return 88 * bj + 4 * pn + (sb & 3); }

__device__ __forceinline__ void norm_row(const float* xrow, const float* g, bf16_t* orow, int lane, const float* part = nullptr, int nparts = 0, float* xw = nullptr) {
    const f32x4* xr = (const f32x4*)xrow + lane; const f32x4* gr = (const f32x4*)g + lane;
    f32x4 v[4]; float s = 0.f;
#pragma unroll
    for (int j = 0; j < 4; ++j) v[j] = xr[64 * j];
    if (nparts > 0) {
        typedef const __attribute__((address_space(1))) f32x4* gv4;
        int p = 0;
        for (; p + 4 <= nparts; p += 4) { f32x4 t[4][4];
#pragma unroll
            for (int q = 0; q < 4; ++q)
#pragma unroll
                for (int j = 0; j < 4; ++j) t[q][j] = *((gv4)(part + (size_t)(p + q) * MS * DM) + lane + 64 * j);
#pragma unroll
            for (int j = 0; j < 4; ++j) v[j] += (t[0][j] + t[1][j]) + (t[2][j] + t[3][j]); }
        for (; p < nparts; ++p) { const f32x4* pr = (const f32x4*)(part + (size_t)p * MS * DM) + lane;
#pragma unroll
            for (int j = 0; j < 4; ++j) v[j] += pr[64 * j]; }
        f32x4* wr_ = (f32x4*)xw + lane;
#pragma unroll
        for (int j = 0; j < 4; ++j) wr_[64 * j] = v[j];
    }
#pragma unroll
    for (int j = 0; j < 4; ++j) s += (v[j].x * v[j].x + v[j].y * v[j].y) + (v[j].z * v[j].z + v[j].w * v[j].w);
    const float rstd = __builtin_amdgcn_rsqf(wave_sum(s) * (1.f / DM) + EPS);
    u32x2* o8 = (u32x2*)orow + lane;
#pragma unroll
    for (int j = 0; j < 4; ++j) { const f32x4 gg = gr[64 * j]; u32x2 w; w.x = cvt_pk_bf16(v[j].x * rstd * gg.x, v[j].y * rstd * gg.y); w.y = cvt_pk_bf16(v[j].z * rstd * gg.z, v[j].w * rstd * gg.w); o8[64 * j] = w; }
}
__device__ __forceinline__ void norm_rows(const float* x, const float* g, bf16_t* XN, int gw, int NGW, int lane) {
    typedef const __attribute__((address_space(1))) f32x4* gv4;
    const f32x4* gr = (const f32x4*)g + lane;
    f32x4 gg[4];
#pragma unroll
    for (int j = 0; j < 4; ++j) gg[j] = gr[64 * j];
    int m = gw; if (m >= MP) return;
    f32x4 vn[4];
#pragma unroll
    for (int j = 0; j < 4; ++j) vn[j] = *((gv4)(x + (size_t)m * DM) + lane + 64 * j);
    for (; m < MP; m += NGW) {
        f32x4 v[4];
#pragma unroll
        for (int j = 0; j < 4; ++j) v[j] = vn[j];
        const int mn = m + NGW;
        if (mn < MP) {
#pragma unroll
            for (int j = 0; j < 4; ++j) vn[j] = *((gv4)(x + (size_t)mn * DM) + lane + 64 * j);
        }
        float sq = 0.f;
#pragma unroll
        for (int j = 0; j < 4; ++j) sq += (v[j].x * v[j].x + v[j].y * v[j].y) + (v[j].z * v[j].z + v[j].w * v[j].w);
        const float rstd = __builtin_amdgcn_rsqf(wave_sum(sq) * (1.f / DM) + EPS);
        __attribute__((address_space(1))) u32x2* o8 = (__attribute__((address_space(1))) u32x2*)(XN + (size_t)m * DM) + lane;
#pragma unroll
        for (int j = 0; j < 4; ++j) { u32x2 w; w.x = cvt_pk_bf16(v[j].x * rstd * gg[j].x, v[j].y * rstd * gg[j].y); w.y = cvt_pk_bf16(v[j].z * rstd * gg[j].z, v[j].w * rstd * gg[j].w); o8[64 * j] = w; }
    }
}
__device__ __forceinline__ void cache_convert(const float* ck, const float* cv, bf16_t* KS, bf16_t* VS, int W, int H, int NBS, int gtid, int gthreads) {
    const int nchunk = SBATCH * H * (W / 32) * 256;
    for (int id = gtid; id < 2 * nchunk; id += gthreads) {
        const bool isv = id >= nchunk; int c = isv ? id - nchunk : id;
        const int within = c & 255; c >>= 8; const int blk = c % (W / 32); c /= (W / 32); const int h = c % H, b = c / H;
        u32x4 w;
        if (!isv) { const int key = within & 31, hi = (within >> 5) & 1, d0 = within >> 6;
            const float* src = ck + ((size_t)(b * W + blk * 32 + key) * H + h) * 64 + 32 * hi + 8 * d0;
            const f32x4 a = *(const f32x4*)src, bb = *(const f32x4*)(src + 4);
            w.x = cvt_pk_bf16(a[0], a[1]); w.y = cvt_pk_bf16(a[2], a[3]); w.z = cvt_pk_bf16(bb[0], bb[1]); w.w = cvt_pk_bf16(bb[2], bb[3]);
            *(u32x4*)(KS + ((size_t)(b * H + h) * NBS + blk) * 2048 + within * 8) = w;
        } else { const int dl = within & 31, hi = (within >> 5) & 1, dblk = (within >> 6) & 1, s = within >> 7;
            float f[8];
#pragma unroll
            for (int j = 0; j < 8; ++j) { const int key = 16 * s + 4 * hi + (j & 3) + 8 * (j >> 2); f[j] = cv[((size_t)(b * W + blk * 32 + key) * H + h) * 64 + 32 * dblk + dl]; }
            w.x = cvt_pk_bf16(f[0], f[1]); w.y = cvt_pk_bf16(f[2], f[3]); w.z = cvt_pk_bf16(f[4], f[5]); w.w = cvt_pk_bf16(f[6], f[7]);
            *(u32x4*)(VS + ((size_t)(b * H + h) * NBS + blk) * 2048 + within * 8) = w;
        }
    }
}
struct TItem { const float* src; bf16_t* dst; int K; int Nsrc; };
__device__ __forceinline__ void t_load(f32x4 (&v)[8], const TItem& t, int lane) {
    const float* p = t.src + (size_t)(lane >> 3) * t.Nsrc + 4 * (lane & 7);
#pragma unroll
    for (int i = 0; i < 8; ++i) v[i] = __builtin_nontemporal_load((const __attribute__((address_space(1))) f32x4*)(p + (size_t)(8 * i) * t.Nsrc));
}
__device__ __forceinline__ void t_store(const f32x4 (&v)[8], const TItem& t, LAS float* scr, int lane) {
    const int c = lane & 7, r = lane >> 3;
#pragma unroll
    for (int i = 0; i < 8; ++i)
#pragma unroll
        for (int e = 0; e < 4; ++e) scr[(4 * c + e) * 65 + r + 8 * i] = v[i][e];
    asm volatile("s_waitcnt lgkmcnt(0)" ::: "memory");
#pragma unroll
    for (int j = 0; j < 4; ++j) { const int n = r + 8 * j; const LAS float* sp = scr + n * 65 + 8 * c;
        u32x4 o; o.x = cvt_pk_bf16(sp[0], sp[1]); o.y = cvt_pk_bf16(sp[2], sp[3]); o.z = cvt_pk_bf16(sp[4], sp[5]); o.w = cvt_pk_bf16(sp[6], sp[7]);
        *(__attribute__((address_space(1))) u32x4*)(t.dst + (size_t)n * t.K + 8 * c) = o; }
    asm volatile("s_waitcnt lgkmcnt(0)" ::: "memory");
}
__device__ __forceinline__ TItem t_decode(const Params& P, unsigned char* ws, int l, int pair, int it) {
    constexpr int I_IN = 16 * (NIN / 32), I_UP = 16 * (NUP / 32);
    TItem t;
    if (pair == 0) {
        if (it < I_IN) { const int nb = it % (NIN / 32), kb = it / (NIN / 32); t.K = DM; t.Nsrc = NIN; t.src = P.in[8] + (size_t)l * DM * NIN + (size_t)(64 * kb) * NIN + 32 * win_srcblk(nb); t.dst = (bf16_t*)(ws + WS_WIN) + (size_t)(32 * nb) * DM + 64 * kb; }
        else { const int r = it - I_IN, nb = r % 32, kb = r / 32; t.K = DM; t.Nsrc = DM; t.src = P.in[16] + (size_t)l * DM * DM + (size_t)(64 * kb) * DM + 32 * nb; t.dst = (bf16_t*)(ws + WS_WOUT) + (size_t)(32 * nb) * DM + 64 * kb; }
    } else {
        if (it < I_UP) { const int nb = it % (NUP / 32), kb = it / (NUP / 32); t.K = DM; t.Nsrc = NUP; t.src = P.in[18] + (size_t)l * DM * NUP + (size_t)(64 * kb) * NUP + 32 * wup_srcblk(nb); t.dst = (bf16_t*)(ws + WS_WUP) + (size_t)(32 * nb) * DM + 64 * kb; }
        else { const int r = it - I_UP, nb = r % 32, kb = r / 32; t.K = DFF; t.Nsrc = DM; t.src = P.in[21] + (size_t)l * DFF * DM + (size_t)(64 * kb) * DM + 32 * nb; t.dst = (bf16_t*)(ws + WS_WDN) + (size_t)(32 * nb) * DFF + 64 * kb; }
    }
    return t;
}
__device__ __forceinline__ void weight_items(const Params& P, int l, int pair, LAS unsigned char* lds, int widx, int nw, int wave_s, int lo_pm = 0, int hi_pm = 1000) {
    int tid_ = phase_tid(wave_s);
    const int lane = tid_ & 63, wave = tid_ >> 6;
    LAS float* scr = (LAS float*)(lds + wave * 16384);
    unsigned char* ws = P.ws; asm volatile("" : "+s"(ws));
    constexpr int I_IN = 16 * (NIN / 32), I_OUT = 16 * (DM / 32), I_UP = 16 * (NUP / 32), I_DN = (DFF / 64) * (DM / 32);
    const int NT = pair == 0 ? I_IN + I_OUT : I_UP + I_DN;
    const int N = (int)((long)NT * hi_pm / 1000);
    int it = (int)((long)NT * lo_pm / 1000) + widx; if (it >= N) return;
    f32x4 va[8], vb[8], vc[8];
    TItem ta = t_decode(P, ws, l, pair, it), tb = ta, tc = ta;
    t_load(va, ta, lane);
    if (it + nw < N) { tb = t_decode(P, ws, l, pair, it + nw); t_load(vb, tb, lane); }
    for (;;) {
        if (it + 2 * nw < N) { tc = t_decode(P, ws, l, pair, it + 2 * nw); t_load(vc, tc, lane); }
        t_store(va, ta, scr, lane);
        if (it + nw >= N) break;
        if (it + 3 * nw < N) { ta = t_decode(P, ws, l, pair, it + 3 * nw); t_load(va, ta, lane); }
        t_store(vb, tb, scr, lane);
        if (it + 2 * nw >= N) break;
        if (it + 4 * nw < N) { tb = t_decode(P, ws, l, pair, it + 4 * nw); t_load(vb, tb, lane); }
        t_store(vc, tc, scr, lane);
        if (it + 3 * nw >= N) break;
        it += 3 * nw;
    }
}
__device__ __forceinline__ void pre_phase(const Params& P, int l, LAS unsigned char* lds, int vcu, int G, const float* xp, const float* xs, int wave_s) {
    int tid_ = phase_tid(wave_s);
    const int tid = tid_, lane = tid & 63, wave = tid >> 6;
    const int gw = vcu * 8 + wave, NGW = G * 8;
    unsigned char* ws = P.ws; asm volatile("" : "+s"(ws));
    if (l == 0) weight_items(P, 0, 0, lds, gw, NGW, wave_s);
    else weight_items(P, l, 0, lds, gw, NGW, wave_s, 550, 1000);
    const int gtid = vcu * 512 + tid, gthreads = G * 512;
    cache_convert(P.in[2] + (size_t)l * SBATCH * 128 * 4 * 64, P.in[3] + (size_t)l * SBATCH * 128 * 4 * 64, (bf16_t*)(ws + WS_KAS), (bf16_t*)(ws + WS_VAS), 128, 4, NBS_A, gtid, gthreads);
    cache_convert(P.in[4] + (size_t)l * SBATCH * 512 * 16 * 64, P.in[5] + (size_t)l * SBATCH * 512 * 16 * 64, (bf16_t*)(ws + WS_KBS), (bf16_t*)(ws + WS_VBS), 512, 16, NBS_B, gtid, gthreads);
    if (l == 0) { const f32x4* src = (const f32x4*)xs; f32x4* dst = (f32x4*)(P.out + (size_t)MP * DM);
        for (int i = gtid; i < MS * DM / 4; i += gthreads) dst[i] = src[i]; }
    const float* g1 = P.in[7] + (size_t)l * DM; bf16_t* XN = (bf16_t*)(ws + WS_XN);
    norm_rows(xp, g1, XN, gw, NGW, lane);
    for (int m = MP + gw; m < MT; m += NGW) {
        if (l == 0) norm_row(xs + (size_t)(m - MP) * DM, g1, XN + (size_t)m * DM, lane);
        else { float* yr = P.out + (size_t)m * DM; norm_row(yr, g1, XN + (size_t)m * DM, lane, (const float*)(ws + WS_PART) + (size_t)(m - MP) * DM, 11, yr); }
    }
}
__device__ __forceinline__ void norm2_phase(const Params& P, int l, int vcu, int G, int wave_s) {
    int tid_ = phase_tid(wave_s);
    const int tid = tid_, lane = tid & 63, wave = tid >> 6; const int gw = vcu * 8 + wave, NGW = G * 8;
    unsigned char* ws = P.ws; const float* x = P.out; asm volatile("" : "+s"(ws), "+s"(x));
    const float* g2 = P.in[17] + (size_t)l * DM; bf16_t* XN = (bf16_t*)(ws + WS_XN);
    norm_rows(x, g2, XN, gw, NGW, lane);
    for (int m = MP + gw; m < MT; m += NGW) {
        { float* yr = P.out + (size_t)m * DM; norm_row(yr, g2, XN + (size_t)m * DM, lane, (const float*)(ws + WS_PART) + (size_t)(m - MP) * DM, 8, yr); }
    }
}
__device__ __forceinline__ void fix_phase(const Params& P, int l, int vcu, int G, int wave_s) {
    int tid_ = phase_tid(wave_s);
    const int gtid = vcu * 512 + tid_, gthreads = G * 512;
    unsigned char* ws = P.ws; asm volatile("" : "+s"(ws));
    const float* cw = P.in[19] + (size_t)l * 3 * NUP; const float* cb = P.in[20] + (size_t)l * NUP;
    const float* HU = (const float*)(ws + WS_HU); const float* US = (const float*)(ws + WS_US); bf16_t* ACT = (bf16_t*)(ws + WS_ACT);
    const float* cprev = P.in[6] + (size_t)l * SBATCH * 2 * NUP;
    float* o_sfc = P.out + O_SFC + (size_t)l * SBATCH * 2 * NUP;
    constexpr int DF4 = DFF / 4, NPF = 256 * 2 * DF4, NSF = 256 * DF4, NSC = SBATCH * 2 * NUP / 4;
    for (int id = gtid; id < NPF + NSF + NSC; id += gthreads) {
        if (id < NPF) {
            const int j = (id % DF4) * 4, rr = (id / DF4) & 1, seg = id / (2 * DF4);
            f32x4 c2[2];
#pragma unroll
            for (int bj = 0; bj < 2; ++bj) { const int col = bj * DFF + j;
                const float* h = HU + (size_t)seg * 4 * NUP + col; const float* hp = HU + (size_t)(seg - 1) * 4 * NUP + col;
                const bool first = (seg & 63) == 0; const f32x4 z = {0.f, 0.f, 0.f, 0.f};
                const f32x4 p62 = first ? z : *(const f32x4*)(hp + 2 * NUP), p63 = first ? z : *(const f32x4*)(hp + 3 * NUP), x0 = *(const f32x4*)h, x1 = *(const f32x4*)(h + NUP);
                const f32x4 w0 = *(const f32x4*)(cw + col), w1 = *(const f32x4*)(cw + NUP + col), w2 = *(const f32x4*)(cw + 2 * NUP + col), bb = *(const f32x4*)(cb + col);
                c2[bj] = rr == 0 ? bb + w0 * p62 + w1 * p63 + w2 * x0 : bb + w0 * p63 + w1 * x0 + w2 * x1; }
            u32x2 w; w.x = cvt_pk_bf16(gelu1(c2[0][0]) * c2[1][0], gelu1(c2[0][1]) * c2[1][1]); w.y = cvt_pk_bf16(gelu1(c2[0][2]) * c2[1][2], gelu1(c2[0][3]) * c2[1][3]);
            *(u32x2*)(ACT + (size_t)(seg * 64 + rr) * DFF + j) = w;
        } else if (id < NPF + NSF) {
            const int r = id - NPF; const int j = (r % DF4) * 4, row = r / DF4, b = row >> 5, t = row & 31;
            f32x4 c2[2];
#pragma unroll
            for (int bj = 0; bj < 2; ++bj) { const int col = bj * DFF + j;
                const f32x4 xm2 = *(const f32x4*)(t >= 2 ? US + (size_t)(row - 2) * NUP + col : cprev + (size_t)(b * 2 + t) * NUP + col);
                const f32x4 xm1 = *(const f32x4*)(t >= 1 ? US + (size_t)(row - 1) * NUP + col : cprev + (size_t)(b * 2 + 1) * NUP + col);
                const f32x4 x0 = *(const f32x4*)(US + (size_t)row * NUP + col);
                c2[bj] = *(const f32x4*)(cb + col) + *(const f32x4*)(cw + col) * xm2 + *(const f32x4*)(cw + NUP + col) * xm1 + *(const f32x4*)(cw + 2 * NUP + col) * x0; }
            u32x2 w; w.x = cvt_pk_bf16(gelu1(c2[0][0]) * c2[1][0], gelu1(c2[0][1]) * c2[1][1]); w.y = cvt_pk_bf16(gelu1(c2[0][2]) * c2[1][2], gelu1(c2[0][3]) * c2[1][3]);
            *(u32x2*)(ACT + (size_t)(MP + row) * DFF + j) = w;
        } else {
            const int r = (id - NPF - NSF) * 4; const int col = r % NUP, k = (r / NUP) & 1, b = r / (2 * NUP);
            *(f32x4*)(o_sfc + r) = *(const f32x4*)(US + (size_t)(b * 32 + 30 + k) * NUP + col);
        }
    }
}

template <int NQB, bool MIXB>
__device__ __forceinline__ void attn_item(bf16_t* Qp, const bf16_t* Kb, const bf16_t* Vb, int kb0, int kb1, int qpos0, float slope_l2, float sink_l2, const LAS float* tbl, int lane) {
    typedef const __attribute__((address_space(1))) bf16x8* gfrag;
    const int r32 = lane & 31, hi = lane >> 5;
    bf16x8 qf[NQB][4];
#pragma unroll
    for (int qb = 0; qb < NQB; ++qb)
#pragma unroll
        for (int d0 = 0; d0 < 4; ++d0) qf[qb][d0] = *(gfrag)(Qp + (size_t)(32 * qb + r32) * DM + 32 * hi + 8 * d0);
    f32x16 o[NQB][2]; float mrun[NQB], lrun[NQB];
#pragma unroll
    for (int qb = 0; qb < NQB; ++qb) { mrun[qb] = -1e30f; lrun[qb] = 0.f;
#pragma unroll
        for (int d = 0; d < 2; ++d)
#pragma unroll
            for (int r = 0; r < 16; ++r) o[qb][d][r] = 0.f; }
    const float SC = 0.125f * LOG2E;
    const float cfar = MIXB ? tbl[256] : 0.f;
    const bf16_t* kp = Kb + (size_t)kb0 * 2048 + hi * 256 + r32 * 8;
    const bf16_t* vp = Vb + (size_t)kb0 * 2048 + hi * 256 + r32 * 8;
    bf16x8 kf[4], vf[4];
    f32x16 sc[NQB], sn[NQB];
#pragma unroll
    for (int i = 0; i < 4; ++i) kf[i] = *(gfrag)(kp + i * 512);
#pragma unroll
    for (int qb = 0; qb < NQB; ++qb) {
#pragma unroll
        for (int r = 0; r < 16; ++r) sc[qb][r] = 0.f;
#pragma unroll
        for (int d0 = 0; d0 < 4; ++d0) sc[qb] = __builtin_amdgcn_mfma_f32_32x32x16_bf16(kf[d0], qf[qb][d0], sc[qb], 0, 0, 0);
    }
    kp += 2048;
    if (kb0 + 1 < kb1) {
#pragma unroll
        for (int i = 0; i < 4; ++i) kf[i] = *(gfrag)(kp + i * 512);
    }
    for (int kb = kb0; kb < kb1; ++kb) {
#pragma unroll
        for (int i = 0; i < 4; ++i) vf[i] = *(gfrag)(vp + i * 512);
        vp += 2048;
        if (kb + 1 < kb1) {
#pragma unroll
            for (int qb = 0; qb < NQB; ++qb) {
#pragma unroll
                for (int r = 0; r < 16; ++r) sn[qb][r] = 0.f;
#pragma unroll
                for (int d0 = 0; d0 < 4; ++d0) sn[qb] = __builtin_amdgcn_mfma_f32_32x32x16_bf16(kf[d0], qf[qb][d0], sn[qb], 0, 0, 0);
            }
            kp += 2048;
            if (kb + 2 < kb1) {
#pragma unroll
                for (int i = 0; i < 4; ++i) kf[i] = *(gfrag)(kp + i * 512);
            }
        }
        const bool far = MIXB && (qpos0 - (kb * 32 + 31) >= 128);
#pragma unroll
        for (int qb = 0; qb < NQB; ++qb) {
            f32x16 s = sc[qb];
            const int dbase = qpos0 + 32 * qb + r32 - kb * 32 - 4 * hi;
            float mx = -1e30f;
            if (far) {
#pragma unroll
                for (int r = 0; r < 16; ++r) { float t = __builtin_fmaf(s[r], SC, cfar); asm("" : "+v"(t)); s[r] = t; mx = __builtin_fmaxf(mx, t); }
            } else {
#pragma unroll
                for (int r = 0; r < 16; ++r) {
                    const int dist = dbase - ((r & 3) + 8 * (r >> 2));
                    float bias;
                    if (MIXB) { int idx = dist < -128 ? -128 : dist; idx = idx > 128 ? 128 : idx; bias = tbl[idx + 128]; }
                    else bias = -slope_l2 * __builtin_fabsf((float)dist);
                    float t = __builtin_fmaf(s[r], SC, bias); asm("" : "+v"(t)); s[r] = t; mx = __builtin_fmaxf(mx, t);
                }
            }
            mx = __builtin_fmaxf(mx, __shfl_xor(mx, 32));
            const float mold = mrun[qb];
            const bool grow = __builtin_amdgcn_ballot_w64(mx > mold + 6.0f) != 0;
            const float mnew = grow ? __builtin_fmaxf(mold, mx) : mold;
            mrun[qb] = mnew;
            float ls = 0.f;
#pragma unroll
            for (int r = 0; r < 16; ++r) { s[r] = __builtin_amdgcn_exp2f(s[r] - mnew); ls += s[r]; }
            if (grow) {
                const float alpha = __builtin_amdgcn_exp2f(mold - mnew);
                lrun[qb] *= alpha;
#pragma unroll
                for (int d = 0; d < 2; ++d)
#pragma unroll
                    for (int r = 0; r < 16; ++r) o[qb][d][r] *= alpha;
            }
            lrun[qb] += ls;
            u32x4 p0, p1;
            p0.x = cvt_pk_bf16(s[0], s[1]); p0.y = cvt_pk_bf16(s[2], s[3]); p0.z = cvt_pk_bf16(s[4], s[5]); p0.w = cvt_pk_bf16(s[6], s[7]);
            p1.x = cvt_pk_bf16(s[8], s[9]); p1.y = cvt_pk_bf16(s[10], s[11]); p1.z = cvt_pk_bf16(s[12], s[13]); p1.w = cvt_pk_bf16(s[14], s[15]);
            const bf16x8 pf0 = __builtin_bit_cast(bf16x8, p0), pf1 = __builtin_bit_cast(bf16x8, p1);
            o[qb][0] = __builtin_amdgcn_mfma_f32_32x32x16_bf16(vf[0], pf0, o[qb][0], 0, 0, 0);
            o[qb][1] = __builtin_amdgcn_mfma_f32_32x32x16_bf16(vf[1], pf0, o[qb][1], 0, 0, 0);
            o[qb][0] = __builtin_amdgcn_mfma_f32_32x32x16_bf16(vf[2], pf1, o[qb][0], 0, 0, 0);
            o[qb][1] = __builtin_amdgcn_mfma_f32_32x32x16_bf16(vf[3], pf1, o[qb][1], 0, 0, 0);
        }
#pragma unroll
        for (int qb = 0; qb < NQB; ++qb) sc[qb] = sn[qb];
    }
#pragma unroll
    for (int qb = 0; qb < NQB; ++qb) {
        float lt = lrun[qb] + __shfl_xor(lrun[qb], 32);
        if (!MIXB) lt += __builtin_amdgcn_exp2f(sink_l2 - mrun[qb]);
        const float inv = 1.0f / lt;
        bf16_t* op = Qp + (size_t)(32 * qb + r32) * DM + 4 * hi;
#pragma unroll
        for (int d = 0; d < 2; ++d)
#pragma unroll
            for (int g = 0; g < 4; ++g) { u32x2 w; w.x = cvt_pk_bf16(o[qb][d][4 * g] * inv, o[qb][d][4 * g + 1] * inv); w.y = cvt_pk_bf16(o[qb][d][4 * g + 2] * inv, o[qb][d][4 * g + 3] * inv);
                *(__attribute__((address_space(1))) u32x2*)(op + 32 * d + 8 * g) = w; }
    }
}
__device__ __forceinline__ void attn_phase(const Params& P, int l, LAS unsigned char* lds, int vcu, int G, int wave_s) {
    int tid_ = phase_tid(wave_s);
    const int tid = tid_, lane = tid & 63, wave = __builtin_amdgcn_readfirstlane(tid >> 6);
    LAS float* tbl = (LAS float*)(lds + wave * 2048);
    unsigned char* ws = P.ws; asm volatile("" : "+s"(ws));
    bf16_t* QA = (bf16_t*)(ws + WS_QA); bf16_t* QB = (bf16_t*)(ws + WS_QB);
    const float* sinks = P.in[14] + l * 16; const float* rel = P.in[15] + (size_t)l * 257 * 16;
    const int gw = vcu * 8 + wave, NGW = G * 8;
    int cur_h = -1;
    for (int id = gw; id < NBATCH * 16 * 64; id += NGW) {
        const int c = id & 63, h = (id >> 6) & 15, b = id >> 10;
        if (h != cur_h) { for (int i = lane; i < 257; i += 64) tbl[i] = rel[i * 16 + h] * LOG2E; cur_h = h; asm volatile("s_waitcnt lgkmcnt(0)" ::: "memory"); }
        const int kb0 = c >= 8 ? 2 * (c - 8) : 0;
        attn_item<2, true>(QB + ((size_t)b * SEQ + c * 64) * DM + h * 64, (const bf16_t*)(ws + WS_KB) + (size_t)(b * 16 + h) * NT32 * 2048, (const bf16_t*)(ws + WS_VB) + (size_t)(b * 16 + h) * NT32 * 2048,
                           kb0, 2 * (c + 1), 64 * c, 0.f, 0.f, tbl, lane);
    }
    for (int id = gw; id < NBATCH * 16 * 64; id += NGW) {
        const int c = id & 63, h = (id >> 6) & 15, b = id >> 10;
        const int kb0 = c >= 2 ? 2 * (c - 2) : 0;
        const float slope = __builtin_amdgcn_exp2f(-0.5f * (float)(h + 1)) * LOG2E;
        attn_item<2, false>(QA + ((size_t)b * SEQ + c * 64) * DM + h * 64, (const bf16_t*)(ws + WS_KA) + (size_t)(b * 4 + (h >> 2)) * NT32 * 2048, (const bf16_t*)(ws + WS_VA) + (size_t)(b * 4 + (h >> 2)) * NT32 * 2048,
                            kb0, 2 * (c + 1), 64 * c, slope, sinks[h] * LOG2E, tbl, lane);
    }
    if (NGW == 2048 && (gw & 63) < 8) {
        const int cs = gw & 63, j = gw >> 6, idx = (cs & 3) * 32 + j, h = idx & 15, b = idx >> 4;
        if (cs < 4) {
            if (h != cur_h) { for (int i = lane; i < 257; i += 64) tbl[i] = rel[i * 16 + h] * LOG2E; cur_h = h; asm volatile("s_waitcnt lgkmcnt(0)" ::: "memory"); }
            attn_item<1, true>(QB + ((size_t)MP + b * STOK) * DM + h * 64, (const bf16_t*)(ws + WS_KBS) + (size_t)(b * 16 + h) * NBS_B * 2048, (const bf16_t*)(ws + WS_VBS) + (size_t)(b * 16 + h) * NBS_B * 2048,
                               0, NBS_B, 512, 0.f, 0.f, tbl, lane);
        } else {
            const float slope = __builtin_amdgcn_exp2f(-0.5f * (float)(h + 1)) * LOG2E;
            attn_item<1, false>(QA + ((size_t)MP + b * STOK) * DM + h * 64, (const bf16_t*)(ws + WS_KAS) + (size_t)(b * 4 + (h >> 2)) * NBS_A * 2048, (const bf16_t*)(ws + WS_VAS) + (size_t)(b * 4 + (h >> 2)) * NBS_A * 2048,
                                0, NBS_A, 128, slope, sinks[h] * LOG2E, tbl, lane);
        }
    } else if (NGW != 2048 && wave == 0) for (int id = vcu; id < 2 * SBATCH * 16; id += G) {
        const int h = id & 15, b = (id >> 4) & 7, mxr = id >> 7;
        if (mxr) {
            if (h != cur_h) { for (int i = lane; i < 257; i += 64) tbl[i] = rel[i * 16 + h] * LOG2E; cur_h = h; asm volatile("s_waitcnt lgkmcnt(0)" ::: "memory"); }
            attn_item<1, true>(QB + ((size_t)MP + b * STOK) * DM + h * 64, (const bf16_t*)(ws + WS_KBS) + (size_t)(b * 16 + h) * NBS_B * 2048, (const bf16_t*)(ws + WS_VBS) + (size_t)(b * 16 + h) * NBS_B * 2048,
                               0, NBS_B, 512, 0.f, 0.f, tbl, lane);
        } else {
            const float slope = __builtin_amdgcn_exp2f(-0.5f * (float)(h + 1)) * LOG2E;
            attn_item<1, false>(QA + ((size_t)MP + b * STOK) * DM + h * 64, (const bf16_t*)(ws + WS_KAS) + (size_t)(b * 4 + (h >> 2)) * NBS_A * 2048, (const bf16_t*)(ws + WS_VAS) + (size_t)(b * 4 + (h >> 2)) * NBS_A * 2048,
                                0, NBS_A, 128, slope, sinks[h] * LOG2E, tbl, lane);
        }
    }
}

#define XB_TMO      128
#define XB_XCNT(j)  (256  + 64 * (j))
#define XB_XSUB(j)  (1280 + 64 * (j))
#define XB_XGEN(j)  (2304 + 64 * (j))
#define XB_TOP      3328
#define XB_TOPGEN   3392
#define XCD_BAR_WORDS 3456
#define XB_SPIN_CAP (1u << 20)
__device__ __forceinline__ unsigned xb_ld(unsigned* p)              { return __hip_atomic_load(p, __ATOMIC_RELAXED, __HIP_MEMORY_SCOPE_AGENT); }
__device__ __forceinline__ unsigned xb_add(unsigned* p, unsigned v) { return __hip_atomic_fetch_add(p, v, __ATOMIC_RELAXED, __HIP_MEMORY_SCOPE_AGENT); }
__device__ __forceinline__ unsigned xb_xcc_id() { return (unsigned)__builtin_amdgcn_s_getreg((3 << 11) | 20) & 0xFu; }
#define XB_SPIN(cond, bar) do { unsigned _sp = 0; while (cond) { __builtin_amdgcn_s_sleep(1); \
    if ((++_sp & 255u) == 0u) { if (xb_ld(&(bar)[XB_TMO])) break; if (_sp > XB_SPIN_CAP) { atomicAdd(&(bar)[XB_TMO], 1u); break; } } } } while (0)
struct XcdBarrier { unsigned* bar; unsigned x; volatile LAS unsigned* st; };
__device__ __forceinline__ void xcd_barrier_complete(unsigned* bar, unsigned x, unsigned& nloc, unsigned& nx) {
    const unsigned G = gridDim.x * gridDim.y * gridDim.z;
    unsigned sum, cnt, mine, sp = 0u;
    for (;;) {
        sum = 0u; cnt = 0u; mine = 0u;
#pragma unroll
        for (unsigned j = 0; j < 16; ++j) { const unsigned c = xb_ld(&bar[XB_XCNT(j)]); sum += c; cnt += (c > 0u) ? 1u : 0u; mine = (j == x) ? c : mine; }
        if (sum == G) break;
        __builtin_amdgcn_s_sleep(1);
        if ((++sp & 255u) == 0u) { if (xb_ld(&bar[XB_TMO])) break; if (sp > XB_SPIN_CAP) { atomicAdd(&bar[XB_TMO], 1u); break; } }
    }
    nloc = mine > 0u ? mine : 1u; nx = cnt > 0u ? cnt : 1u;
}
__device__ __forceinline__ void xcd_barrier(const XcdBarrier& b, int wave_s) {
    asm volatile("s_waitcnt vmcnt(0)" ::: "memory");
    __syncthreads();
    if (wave_s == 0) { int lane; asm volatile("v_mbcnt_lo_u32_b32 %0, -1, 0\n\tv_mbcnt_hi_u32_b32 %0, -1, %0" : "=v"(lane));
    if (lane == 0) {
        unsigned* bar = b.bar;
        __builtin_amdgcn_s_waitcnt(0);
        unsigned nloc = b.st[0], nx = b.st[1];
        if (nloc == 0u) { xcd_barrier_complete(bar, b.x, nloc, nx); b.st[0] = nloc; b.st[1] = nx; }
        const unsigned old = xb_add(&bar[XB_XSUB(b.x)], 1u);
        const unsigned gen = old / nloc;
        if (old + 1u == (gen + 1u) * nloc) {
            __builtin_amdgcn_fence(__ATOMIC_RELEASE, "agent");
            asm volatile("s_waitcnt vmcnt(0)" ::: "memory");
            const unsigned og = xb_add(&bar[XB_TOP], 1u);
            const unsigned tg = og / nx;
            if (og + 1u == (tg + 1u) * nx) xb_add(&bar[XB_TOPGEN], 1u);
            else XB_SPIN(xb_ld(&bar[XB_TOPGEN]) == tg, bar);
            __builtin_amdgcn_fence(__ATOMIC_ACQUIRE, "agent");
            xb_add(&bar[XB_XGEN(b.x)], 1u);
            asm volatile("s_waitcnt vmcnt(0)" ::: "memory");
        } else {
            XB_SPIN(xb_ld(&bar[XB_XGEN(b.x)]) == gen, bar);
            __builtin_amdgcn_fence(__ATOMIC_ACQUIRE, "agent");
            asm volatile("s_waitcnt vmcnt(0)" ::: "memory");
        }
    } }
    __syncthreads();
}
#ifndef PROBE_MASK
#define PROBE_MASK 0u
#endif
#define PH_BEGIN(BIT) unsigned long long _t0_##BIT = 0; if ((PROBE_MASK >> (BIT)) & 1u) _t0_##BIT = __builtin_amdgcn_s_memrealtime();
#define PH_END(BIT) if ((PROBE_MASK >> (BIT)) & 1u) { const unsigned long long _t1 = __builtin_amdgcn_s_memrealtime(); const unsigned long long _dt = _t1 - _t0_##BIT; while (__builtin_amdgcn_s_memrealtime() - _t1 < _dt) __builtin_amdgcn_s_sleep(8); }
constexpr int LDS_BYTES = 135168;
__global__ void __launch_bounds__(512, 2) fwd_megakernel(Params P) {
    extern __shared__ __attribute__((aligned(16))) unsigned char lds_raw[];
    LAS unsigned char* lds = (LAS unsigned char*)lds_raw;
    cg::grid_group grid = cg::this_grid();
    const int G = gridDim.x, bx = blockIdx.x;
    const int wave_s = __builtin_amdgcn_readfirstlane((int)threadIdx.x >> 6);
    const int vcu = (G % 8 == 0) ? (bx % 8) * (G / 8) + bx / 8 : bx;
    unsigned char* ws = P.ws;
    bf16_t* XN = (bf16_t*)(ws + WS_XN);
    volatile LAS unsigned* bst = (volatile LAS unsigned*)(lds + 131072 + 64);
    if (threadIdx.x < 2) bst[threadIdx.x] = 0u;
    __syncthreads();
    XcdBarrier bar; bar.bar = (unsigned*)ws + 1024; bar.x = xb_xcc_id(); bar.st = bst;
    if (threadIdx.x == 0) (void)xb_add(&bar.bar[XB_XCNT(bar.x)], 1u);
#define GRID_BAR() xcd_barrier(bar, wave_s)
    if (P.ws == nullptr) grid.sync();
    float* Y = P.out;

    for (int l = 0; l < DEPTH; ++l) {
        PH_BEGIN(0)
#ifndef X_NOPRE
        pre_phase(P, l, lds, vcu, G, l == 0 ? P.in[0] : Y, l == 0 ? P.in[1] : Y + (size_t)MP * DM, wave_s);
#endif
        PH_END(0)
        GRID_BAR();
        {
            PH_BEGIN(1)
            pg8::Gemm g{XN, (const bf16_t*)(ws + WS_WIN), MT, NIN, DM}; pg8::StaticOrder S; S.init(18, 26, 1, 16, G, bx);
            EpiG1a E{ws, P.out, P.in[10] + l * 64, P.in[11] + l * 64, P.in[12] + l * 64, P.in[13] + l * 64, P.in[9] + (size_t)l * 2 * DM, l};
#ifndef X_NOG1A
            pg8::gemm_phase<EpiG1a>(lds, g, S, E, wave_s);
#endif
            { const int rem = (64 * 18 + 26) % G, first = rem, nidle = rem ? G - rem : G;
              if (bx >= first) weight_items(P, l, 1, lds, (bx - first) * 8 + wave_s, nidle * 8, wave_s); }
            PH_END(1)
        }
        GRID_BAR();
        PH_BEGIN(2)
#ifndef X_NOATT
        attn_phase(P, l, lds, vcu, G, wave_s);
#endif
        PH_END(2)
        GRID_BAR();
        {
            PH_BEGIN(3)
            pg8::Gemm g{XN, (const bf16_t*)(ws + WS_WIN) + (size_t)NQKV * DM, MT, NIN - NQKV, DM}; pg8::StaticOrder S; S.init(8, 0, 1, 16, G, bx);
            EpiG1b E{(bf16_t*)(ws + WS_QA), (const bf16_t*)(ws + WS_QB), P.in[9] + (size_t)l * 2 * DM};
            {
                const int tidm = phase_tid(wave_s);
                for (int r = vcu; r < MS; r += G) {
                    bf16_t* oa = (bf16_t*)(ws + WS_QA) + (size_t)(MP + r) * DM + 2 * tidm; const bf16_t* ob = (const bf16_t*)(ws + WS_QB) + (size_t)(MP + r) * DM + 2 * tidm;
                    const bf16_t* gs = (const bf16_t*)(ws + WS_GS) + (size_t)r * 2048 + 2 * tidm;
                    const unsigned wa = *(const unsigned*)oa, wb = *(const unsigned*)ob, ga = *(const unsigned*)gs, gb = *(const unsigned*)(gs + DM);
                    const float m0 = bf2f((unsigned short)ga) * bf2f((unsigned short)wa) + bf2f((unsigned short)gb) * bf2f((unsigned short)wb);
                    const float m1 = bf2f((unsigned short)(ga >> 16)) * bf2f((unsigned short)(wa >> 16)) + bf2f((unsigned short)(gb >> 16)) * bf2f((unsigned short)(wb >> 16));
                    *(unsigned*)oa = cvt_pk_bf16(m0, m1);
                }
            }
#ifndef X_NOG1B
            pg8::gemm_phase<EpiG1b>(lds, g, S, E, wave_s);
#endif
            PH_END(3)
        }
        GRID_BAR();
        {
            PH_BEGIN(4)
            pg8::Gemm g{(const bf16_t*)(ws + WS_QA), (const bf16_t*)(ws + WS_WOUT), MT, DM, DM}; pg8::StaticOrder S; S.init(4, 4, 8, 16, G, bx);
            EpiRes E{l == 0 ? P.in[0] : Y, Y, (float*)(ws + WS_PART)};
            pg8::gemm_phase<EpiRes>(lds, g, S, E, wave_s);
            PH_END(4)
        }
        GRID_BAR();
        { PH_BEGIN(5)
        norm2_phase(P, l, vcu, G, wave_s);
        PH_END(5) }
        GRID_BAR();
        {
            PH_BEGIN(6)
            pg8::Gemm g{XN, (const bf16_t*)(ws + WS_WUP), MT, NUP, DM}; pg8::StaticOrder S; S.init(22, 22, 1, 16, G, bx);
            EpiG3 E{ws, P.out + O_PFC + (size_t)l * NBATCH * 2 * NUP, P.in[19] + (size_t)l * 3 * NUP, P.in[20] + (size_t)l * NUP};
#ifndef X_NOG3
            pg8::gemm_phase<EpiG3>(lds, g, S, E, wave_s);
#endif
            if (l + 1 < DEPTH) { const int rem = (64 * 22 + 22) % G, first = rem, nidle = rem ? G - rem : G;
              if (bx >= first) weight_items(P, l + 1, 0, lds, (bx - first) * 8 + wave_s, nidle * 8, wave_s, 0, 550); }
            PH_END(6)
        }
        GRID_BAR();
        { PH_BEGIN(7)
#ifndef X_NOFIX
        fix_phase(P, l, vcu, G, wave_s);
#endif
        PH_END(7) }
        GRID_BAR();
        {
            PH_BEGIN(8)
            pg8::Gemm g{(const bf16_t*)(ws + WS_ACT), (const bf16_t*)(ws + WS_WDN), MT, DM, DFF}; pg8::StaticOrder S; S.init(4, 4, 11, 44, G, bx);
                        EpiRes E{Y, Y, (float*)(ws + WS_PART)};
            pg8::gemm_phase<EpiRes>(lds, g, S, E, wave_s);
            PH_END(8)
        }
        GRID_BAR();
    }
    {
        const int tidt = phase_tid(wave_s), gtid = vcu * 512 + tidt;
        f32x4* ys = (f32x4*)(Y + (size_t)MP * DM); const f32x4* pp = (const f32x4*)(ws + WS_PART);
        for (int i = gtid; i < MS * DM / 4; i += G * 512) { f32x4 v = ys[i];
#pragma unroll
            for (int p = 0; p < 11; ++p) v += pp[(size_t)p * (MS * DM / 4) + i];
            ys[i] = v; }
    }
}

extern "C" void kernel_launch(void* const* d_in, const int* in_sizes, int n_in, void* d_out, int out_size, void* d_ws, size_t ws_size, hipStream_t stream) {
    static int grid_blocks = 0;
    if (grid_blocks == 0) {
        if (n_in != 22 || (size_t)out_size != O_END || ws_size < WS_END) { fprintf(stderr, "kernel_launch: unexpected shapes: n_in %d out %d ws %zu\n", n_in, out_size, ws_size); grid_blocks = -1; return; }
        int dev = 0, cus = 0, per_cu = 0;
        hipGetDevice(&dev); hipDeviceGetAttribute(&cus, hipDeviceAttributeMultiprocessorCount, dev);
        hipFuncSetAttribute((const void*)fwd_megakernel, hipFuncAttributeMaxDynamicSharedMemorySize, LDS_BYTES);
        hipOccupancyMaxActiveBlocksPerMultiprocessor(&per_cu, (const void*)fwd_megakernel, 512, LDS_BYTES);
        if (per_cu < 1) { fprintf(stderr, "kernel_launch: occupancy query says %d blocks/CU\n", per_cu); per_cu = 1; }
        (void)hipGetLastError();
        grid_blocks = cus;
    }
    if (grid_blocks < 0) return;
    (void)hipMemsetAsync(d_ws, 0, 65536, stream);
    Params p{};
    for (int i = 0; i < 22; ++i) p.in[i] = (const float*)d_in[i];
    p.out = (float*)d_out; p.ws = (unsigned char*)d_ws;
    void* args[] = {&p};
    hipError_t e = hipLaunchCooperativeKernel((const void*)fwd_megakernel, dim3(grid_blocks), dim3(512), args, LDS_BYTES, stream);
    if (e != hipSuccess) fprintf(stderr, "cooperative launch failed: %s (grid %d)\n", hipGetErrorString(e), grid_blocks);
}
```

```cpp
#include <hip/hip_runtime.h>
#include <hip/hip_cooperative_groups.h>
#include <cstdio>
#include <cstdint>
namespace cg = cooperative_groups;

#define LAS __attribute__((address_space(3)))
typedef unsigned short bf16_t;
typedef short bf16x8 __attribute__((ext_vector_type(8)));
typedef float f32x4 __attribute__((ext_vector_type(4)));
typedef float f32x2 __attribute__((ext_vector_type(2)));
typedef float f32x16 __attribute__((ext_vector_type(16)));
typedef unsigned u32x4 __attribute__((ext_vector_type(4)));
typedef unsigned u32x2 __attribute__((ext_vector_type(2)));
typedef __bf16 bf16x2_t __attribute__((ext_vector_type(2)));

constexpr int DM = 1024, MP = 16384, MS = 256, MT = MP + MS, SEQ = 4096, NBATCH = 4, SBATCH = 8, STOK = 32;
constexpr int NIN = 6656, NQKV = 4608, DFF = 2816, NUP = 5632, DEPTH = 2;
constexpr int NT32 = SEQ / 32;
constexpr int NBS_A = 5, NBS_B = 17;
constexpr float EPS = 1e-6f, LOG2E = 1.4426950408889634f;

constexpr size_t O_YP = 0, O_YS = 16777216, O_PAK = 17039360, O_PAV = 17301504, O_PBK = 17563648, O_PBV = 21757952,
                 O_PFC = 25952256, O_SAK = 26042368, O_SAV = 26173440, O_SBK = 26304512, O_SBV = 26828800, O_SFC = 27353088,
                 O_END = 27533312;
constexpr size_t MiB = 1u << 20;
constexpr size_t WS_WIN = 1 * MiB, WS_WOUT = 14 * MiB, WS_WUP = 16 * MiB, WS_WDN = 27 * MiB, WS_XN = 33 * MiB, WS_QA = 66 * MiB, WS_QB = 99 * MiB,
                 WS_KA = 132 * MiB, WS_VA = 140 * MiB, WS_KB = 148 * MiB, WS_VB = 180 * MiB, WS_KAS = 212 * MiB, WS_VAS = 213 * MiB,
                 WS_KBS = 214 * MiB, WS_VBS = 223 * MiB, WS_ACT = 66 * MiB, WS_HU = 156 * MiB, WS_US = 178 * MiB, WS_GS = 232 * MiB, WS_PART = 233 * MiB, WS_END = 245 * MiB;

struct Params { const float* in[22]; float* out; unsigned char* ws; };

__device__ __forceinline__ unsigned cvt_pk_bf16(float lo, float hi) { f32x2 v = {lo, hi}; bf16x2_t b = __builtin_convertvector(v, bf16x2_t); return __builtin_bit_cast(unsigned, b); }
__device__ __forceinline__ float bf2f(unsigned short b) { return __builtin_bit_cast(float, (unsigned)b << 16); }

__device__ __forceinline__ int phase_tid(int wave_s) { int lane; asm volatile("v_mbcnt_lo_u32_b32 %0, -1, 0\n\tv_mbcnt_hi_u32_b32 %0, -1, %0" : "=v"(lane)); return wave_s * 64 + lane; }
namespace pg8 {
constexpr int BM = 256, BK = 64, HALF = 128, HTB = HALF * BK * 2, STAGE_BYTES = 8 * HTB, NXCD = 8, WGM = 2;
__host__ __device__ __forceinline__ int lds_byte(int r, int c) { const int st = (r >> 4) * 2 + (c >> 5), rr = r & 15, cc = c & 31, ob = rr * 64 + cc * 2; return st * 1024 + (ob ^ (((ob >> 9) & 1) << 5)); }
__host__ __device__ __forceinline__ void stage_rc(int b, int& R, int& C) { const int st = b / 1024, sb = b % 1024, swz = sb ^ (((sb >> 9) & 1) << 5); R = (st >> 1) * 16 + swz / 64; C = (st & 1) * 32 + (swz % 64) / 2; }
__host__ __device__ __forceinline__ int perm32(int rho) { const int n = rho >> 4, i = rho & 15; return 8 * (i >> 2) + 4 * n + (i & 3); }

struct Unit { int pm, pn, k0, nt; };
struct Gemm { const bf16_t* A; const bf16_t* Bt; int M, N, K; };

struct StaticOrder {
    int nNp, nP, nNs, nS, ntp, nts, G, c;
    __device__ void init(int nNp_, int nNs_, int nsplit, int ntfull, int G_, int c_) { nNp = nNp_; nP = 64 * nNp_; nNs = nNs_; nS = nNs_ * nsplit; ntp = ntfull; nts = ntfull / nsplit; G = G_; c = c_; }
    __device__ bool next(int i, Unit& u) const {
        const int L = i * G + c; if (L >= nP + nS) return false;
        if (L >= nP) { const int sI = L - nP; u.pm = 64; u.pn = sI % nNs; u.k0 = (sI / nNs) * nts; u.nt = nts; return true; }
        int wgid = L; { const int q = nP / NXCD, xcd = wgid % NXCD, off = wgid / NXCD; wgid = xcd * q + off; }
        const int nig = WGM * nNp, gid = wgid / nig, fm = gid * WGM;
        u.pm = fm + ((wgid % nig) % WGM); u.pn = (wgid % nig) / WGM; u.k0 = 0; u.nt = ntp; return true;
    }
};

template <class Epi>
__device__ __forceinline__ void gemm_phase(LAS unsigned char* lds, Gemm g, const StaticOrder& S, const Epi& E, int wave_s) {
    int tid_ = phase_tid(wave_s);
    asm volatile("" : "+s"(g.A), "+s"(g.Bt));
    const int tid = tid_, wid = __builtin_amdgcn_readfirstlane(tid >> 6), lane = tid & 63, wr = wid >> 2, wc = wid & 3, fr = lane & 15, fq = lane >> 4;
    const int K = g.K;
    unsigned voffA[2], voffB[2];
#pragma unroll
    for (int i = 0; i < 2; ++i) { int R, C; stage_rc(tid * 16 + i * 8192, R, C); const int Rb = (R & ~31) + perm32(R & 31);
        const int Ra = Epi::APERM ? ((R & ~63) + 4 * (R & 15) + ((R >> 4) & 3)) : R;
        voffA[i] = (unsigned)(Ra * K + C) * 2u; voffB[i] = (unsigned)(Rb * K + C) * 2u; }
    const size_t kstep = (size_t)(BK * 2);
    const size_t hstep = (size_t)HALF * K * 2;
    const size_t tstep = 2 * hstep;
    const unsigned ldsw = (unsigned)wid * 1024u;
    const int aoff = lds_byte(wr * 64 + fr, fq * 8), boff = lds_byte(wc * 32 + fr, fq * 8);
#define PG8_SA(b, h) (((b) * 2 + (h)) * HTB)
#define PG8_SB(b, h) ((4 + (b) * 2 + (h)) * HTB)
#define PG8_STAGE(bufoff, gbase, voff) do { _Pragma("unroll") for (int _i = 0; _i < 2; ++_i) \
        __builtin_amdgcn_global_load_lds((const unsigned*)((const char*)(gbase) + (voff)[_i]), (LAS unsigned*)(lds + (bufoff) + ldsw + _i * 8192), 16, 0, 0); } while (0)
#define PG8_LDA(dst, b, h) do { _Pragma("unroll") for (int m = 0; m < 4; ++m) _Pragma("unroll") for (int k = 0; k < 2; ++k) dst[m][k] = *(const LAS bf16x8*)(lds + PG8_SA(b, h) + aoff + m * 2048 + k * 1024); } while (0)
#define PG8_LDB(dst, b, h) do { _Pragma("unroll") for (int n = 0; n < 2; ++n) _Pragma("unroll") for (int k = 0; k < 2; ++k) dst[n][k] = *(const LAS bf16x8*)(lds + PG8_SB(b, h) + boff + n * 2048 + k * 1024); } while (0)
#define PG8_MMA(ai, bj, At, Bt) do { __builtin_amdgcn_s_setprio(1); _Pragma("unroll") for (int m = 0; m < 4; ++m) _Pragma("unroll") for (int n = 0; n < 2; ++n) _Pragma("unroll") for (int k = 0; k < 2; ++k) \
        acc[ai][bj][m][n] = __builtin_amdgcn_mfma_f32_16x16x32_bf16(Bt[n][k], At[m][k], acc[ai][bj][m][n], 0, 0, 0); __builtin_amdgcn_s_setprio(0); } while (0)
#define PG8_WAIT_V(n) asm volatile("s_waitcnt vmcnt(" #n ")" ::: "memory")
#define PG8_WAIT_L(n) asm volatile("s_waitcnt lgkmcnt(" #n ")" ::: "memory")
#define PG8_BAR __builtin_amdgcn_s_barrier()
#define PG8_SCHED __builtin_amdgcn_sched_barrier(0)
    Unit cur, nxt; int ui = 0;
    if (!S.next(0, cur)) return;
    f32x4 acc[2][2][4][2];
#pragma unroll
    for (int a = 0; a < 2; ++a)
#pragma unroll
        for (int b = 0; b < 2; ++b)
#pragma unroll
            for (int m = 0; m < 4; ++m)
#pragma unroll
                for (int n = 0; n < 2; ++n) acc[a][b][m][n] = (f32x4){0.f, 0.f, 0.f, 0.f};
    bf16x8 At[4][2], B0[2][2], B1[2][2];
    const char* cA = (const char*)g.A + (size_t)cur.pm * tstep + (size_t)cur.k0 * kstep; const char* cB = (const char*)g.Bt + (size_t)cur.pn * tstep + (size_t)cur.k0 * kstep;
    PG8_STAGE(PG8_SB(0, 0), cB, voffB); PG8_STAGE(PG8_SB(0, 1), cB + hstep, voffB); PG8_STAGE(PG8_SA(0, 0), cA, voffA); PG8_STAGE(PG8_SA(0, 1), cA + hstep, voffA);
    if (wr == 1) PG8_BAR;
    PG8_WAIT_V(2); PG8_BAR;
    PG8_STAGE(PG8_SB(1, 0), cB + kstep, voffB); PG8_STAGE(PG8_SA(1, 0), cA + kstep, voffA); PG8_STAGE(PG8_SB(1, 1), cB + hstep + kstep, voffB);
    PG8_WAIT_V(6); PG8_BAR;
    for (;;) {
        const bool has_next = S.next(ui + 1, nxt);
        const char* nA = has_next ? (const char*)g.A + (size_t)nxt.pm * tstep + (size_t)nxt.k0 * kstep : cA; const char* nB = has_next ? (const char*)g.Bt + (size_t)nxt.pn * tstep + (size_t)nxt.k0 * kstep : cB;
        const int nt = cur.nt;
        for (int t = 0; t < nt; t += 2) {
            const bool last = (t == nt - 2);
            const char* a1 = cA + (size_t)(t + 1) * kstep;
            const char* a2 = last ? nA : cA + (size_t)(t + 2) * kstep; const char* b2 = last ? nB : cB + (size_t)(t + 2) * kstep;
            const char* a3 = a2 + kstep; const char* b3 = b2 + kstep;
            PG8_LDB(B0, 0, 0); PG8_LDB(B1, 0, 1); PG8_SCHED; PG8_LDA(At, 0, 0); PG8_STAGE(PG8_SA(1, 1), a1 + hstep, voffA);
            PG8_WAIT_V(8); PG8_WAIT_L(0); PG8_BAR; PG8_MMA(0, 0, At, B0); PG8_MMA(0, 1, At, B1); PG8_BAR; PG8_SCHED;
            PG8_LDA(At, 0, 1); PG8_STAGE(PG8_SB(0, 0), b2, voffB); PG8_STAGE(PG8_SB(0, 1), b2 + hstep, voffB); PG8_STAGE(PG8_SA(0, 0), a2, voffA);
            PG8_WAIT_V(8); PG8_WAIT_L(0); PG8_BAR; PG8_MMA(1, 0, At, B0); PG8_MMA(1, 1, At, B1); PG8_BAR; PG8_SCHED;
            PG8_LDB(B0, 1, 0); PG8_LDB(B1, 1, 1); PG8_SCHED; PG8_LDA(At, 1, 0); PG8_STAGE(PG8_SA(0, 1), a2 + hstep, voffA);
            PG8_WAIT_V(8); PG8_WAIT_L(0); PG8_BAR; PG8_MMA(0, 0, At, B0); PG8_MMA(0, 1, At, B1); PG8_BAR; PG8_SCHED;
            PG8_LDA(At, 1, 1); PG8_STAGE(PG8_SB(1, 0), b3, voffB); PG8_STAGE(PG8_SB(1, 1), b3 + hstep, voffB); PG8_STAGE(PG8_SA(1, 0), a3, voffA);
            PG8_WAIT_V(8); PG8_WAIT_L(0); PG8_BAR; PG8_MMA(1, 0, At, B0); PG8_MMA(1, 1, At, B1); PG8_BAR; PG8_SCHED;
        }
        if (wr == 0) PG8_BAR;
        E(acc, cur, wr, wc, fr, fq);
        if (!has_next) break;
#pragma unroll
        for (int a = 0; a < 2; ++a)
#pragma unroll
            for (int b = 0; b < 2; ++b)
#pragma unroll
                for (int m = 0; m < 4; ++m)
#pragma unroll
                    for (int n = 0; n < 2; ++n) acc[a][b][m][n] = (f32x4){0.f, 0.f, 0.f, 0.f};
        cur = nxt; cA = nA; cB = nB; ++ui;
        if (wr == 1) PG8_BAR;
    }
    PG8_WAIT_V(0);
    PG8_BAR;
#undef PG8_SA
#undef PG8_SB
#undef PG8_STAGE
#undef PG8_LDA
#undef PG8_LDB
#undef PG8_MMA
#undef PG8_WAIT_V
#undef PG8_WAIT_L
#undef PG8_BAR
#undef PG8_SCHED
}
}
using pg8::Unit;
typedef const f32x4 (&AccRef)[2][2][4][2];

__device__ __forceinline__ float gelu1(float v) {
    const float av = __builtin_fabsf(v), d = av * 0.2316418882f + 1.0f;
    const float t = __builtin_amdgcn_rcpf(d);
    float q = t * 0.5307027145f + (-0.7265760135f); q = q * t + 0.7107068705f; q = q * t + (-0.142248368f); q = q * t + 0.127414796f; q = q * t;
    const float e = __builtin_amdgcn_exp2f((v * v) * (-0.72134752044f));
    const float m = v * (q * e), r = v - m;
    return v < 0.f ? m : r;
}
__device__ __forceinline__ float sigmoidf_(float x) { return __builtin_amdgcn_rcpf(1.0f + __builtin_amdgcn_exp2f(-x * LOG2E)); }

struct EpiG1a {
    static constexpr bool APERM = false;
    unsigned char* ws; float* out; const float *gqa, *gka, *gqb, *gkb; const float* bg; int l;
    __device__ __forceinline__ void operator()(AccRef acc, const Unit& u, int wr, int wc, int fr, int fq) const {
        asm volatile("" : "+v"(fr), "+v"(fq));
        const int pn = u.pn; const bool samp = (u.pm == 64);
        if (pn >= 18) {
            bf16_t* GS = (bf16_t*)(ws + WS_GS); const int c0 = (pn - 18) * 128 + wc * 32 + 8 * fq;
#pragma unroll
            for (int bj = 0; bj < 2; ++bj) {
                const f32x4 b0 = *(const f32x4*)(bg + bj * DM + c0), b1 = *(const f32x4*)(bg + bj * DM + c0 + 4);
#pragma unroll
                for (int ai = 0; ai < 2; ++ai)
#pragma unroll
                    for (int m = 0; m < 4; ++m) {
                        const f32x4 a = acc[ai][bj][m][0] + b0, c = acc[ai][bj][m][1] + b1;
                        u32x4 w; w.x = cvt_pk_bf16(sigmoidf_(a[0]), sigmoidf_(a[1])); w.y = cvt_pk_bf16(sigmoidf_(a[2]), sigmoidf_(a[3])); w.z = cvt_pk_bf16(sigmoidf_(c[0]), sigmoidf_(c[1])); w.w = cvt_pk_bf16(sigmoidf_(c[2]), sigmoidf_(c[3]));
                        *(u32x4*)(GS + (size_t)(ai * 128 + wr * 64 + m * 16 + fr) * 2048 + bj * DM + c0) = w;
                    }
            }
            return;
        }
        int ty, hs, mb;
        if (pn < 4) { ty = 0; mb = 0; hs = pn * 4 + wc; } else if (pn == 4) { ty = 1; mb = 0; hs = wc; } else if (pn == 5) { ty = 2; mb = 0; hs = wc; }
        else if (pn < 10) { ty = 0; mb = 1; hs = (pn - 6) * 4 + wc; } else if (pn < 14) { ty = 1; mb = 1; hs = (pn - 10) * 4 + wc; } else { ty = 2; mb = 1; hs = (pn - 14) * 4 + wc; }
        if (ty == 0) {
            bf16_t* Q = (bf16_t*)(ws + (mb ? WS_QB : WS_QA)); const float* gg = mb ? gqb : gqa;
            f32x4 gv[2][2];
#pragma unroll
            for (int bj = 0; bj < 2; ++bj)
#pragma unroll
                for (int n = 0; n < 2; ++n) gv[bj][n] = *(const f32x4*)(gg + 32 * bj + 8 * fq + 4 * n);
#pragma unroll
            for (int ai = 0; ai < 2; ++ai)
#pragma unroll
                for (int m = 0; m < 4; ++m) {
                    float ss = 0.f;
#pragma unroll
                    for (int bj = 0; bj < 2; ++bj)
#pragma unroll
                        for (int n = 0; n < 2; ++n) { const f32x4 x = acc[ai][bj][m][n]; ss += (x[0] * x[0] + x[1] * x[1]) + (x[2] * x[2] + x[3] * x[3]); }
                    ss += __shfl_xor(ss, 16); ss += __shfl_xor(ss, 32);
                    const float rs = __builtin_amdgcn_rsqf(ss * (1.0f / 64.0f) + EPS);
                    const size_t row = (size_t)u.pm * 256 + ai * 128 + wr * 64 + m * 16 + fr;
                    bf16_t* qp = Q + row * DM + hs * 64 + 8 * fq;
#pragma unroll
                    for (int bj = 0; bj < 2; ++bj) {
                        const f32x4 a = acc[ai][bj][m][0] * rs * gv[bj][0], b = acc[ai][bj][m][1] * rs * gv[bj][1];
                        u32x4 w; w.x = cvt_pk_bf16(a[0], a[1]); w.y = cvt_pk_bf16(a[2], a[3]); w.z = cvt_pk_bf16(b[0], b[1]); w.w = cvt_pk_bf16(b[2], b[3]);
                        *(u32x4*)(qp + 32 * bj) = w;
                    }
                }
            return;
        }
        const int H = mb ? 16 : 4, W = mb ? 512 : 128, NBS = mb ? NBS_B : NBS_A;
        bf16_t* KVp = (bf16_t*)(ws + ((ty == 1) ? (mb ? WS_KB : WS_KA) : (mb ? WS_VB : WS_VA)));
        bf16_t* KVs = (bf16_t*)(ws + ((ty == 1) ? (mb ? WS_KBS : WS_KAS) : (mb ? WS_VBS : WS_VAS)));
        float* op = out + ((ty == 1) ? (mb ? O_PBK : O_PAK) : (mb ? O_PBV : O_PAV)) + (size_t)l * NBATCH * W * H * 64;
        float* os = out + ((ty == 1) ? (mb ? O_SBK : O_SAK) : (mb ? O_SBV : O_SAV)) + (size_t)l * SBATCH * STOK * H * 64;
        f32x4 gv[2][2];
#pragma unroll
        for (int bj = 0; bj < 2; ++bj)
#pragma unroll
            for (int n = 0; n < 2; ++n) gv[bj][n] = (ty == 1) ? *(const f32x4*)((mb ? gkb : gka) + 32 * bj + 8 * fq + 4 * n) : (f32x4){1.f, 1.f, 1.f, 1.f};
#pragma unroll
        for (int ai = 0; ai < 2; ++ai)
#pragma unroll
            for (int m = 0; m < 4; ++m) {
                float rs = 1.0f;
                if (ty == 1) {
                    float ss = 0.f;
#pragma unroll
                    for (int bj = 0; bj < 2; ++bj)
#pragma unroll
                        for (int n = 0; n < 2; ++n) { const f32x4 x = acc[ai][bj][m][n]; ss += (x[0] * x[0] + x[1] * x[1]) + (x[2] * x[2] + x[3] * x[3]); }
                    ss += __shfl_xor(ss, 16); ss += __shfl_xor(ss, 32);
                    rs = __builtin_amdgcn_rsqf(ss * (1.0f / 64.0f) + EPS);
                }
                const int rloc = ai * 128 + wr * 64 + m * 16 + fr;
                int b, t, kidx; bf16_t* blk; float* fo = nullptr;
                if (!samp) { b = u.pm >> 4; t = (u.pm & 15) * 256 + rloc; kidx = t; blk = KVp + ((size_t)(b * H + hs) * NT32 + (t >> 5)) * 2048;
                    if (t >= SEQ - W) fo = op + ((size_t)(b * W + (t - (SEQ - W))) * H + hs) * 64; }
                else { b = rloc >> 5; t = rloc & 31; kidx = W + t; blk = KVs + ((size_t)(b * H + hs) * NBS + (kidx >> 5)) * 2048;
                    fo = os + ((size_t)(b * STOK + t) * H + hs) * 64; }
                const int tt = kidx & 31;
#pragma unroll
                for (int bj = 0; bj < 2; ++bj) {
                    const f32x4 a = acc[ai][bj][m][0] * rs * gv[bj][0], c = acc[ai][bj][m][1] * rs * gv[bj][1];
                    if (fo) { *(f32x4*)(fo + 32 * bj + 8 * fq) = a; *(f32x4*)(fo + 32 * bj + 8 * fq + 4) = c; }
                    if (ty == 1) {
                        u32x4 w; w.x = cvt_pk_bf16(a[0], a[1]); w.y = cvt_pk_bf16(a[2], a[3]); w.z = cvt_pk_bf16(c[0], c[1]); w.w = cvt_pk_bf16(c[2], c[3]);
                        *(u32x4*)(blk + ((fq * 2 + bj) * 32 + tt) * 8) = w;
                    } else {
                        const int s = tt >> 4, u16 = tt & 15, hi = (u16 >> 2) & 1, j = (u16 & 3) + 4 * (u16 >> 3);
                        bf16_t* vp = blk + (((s * 2 + bj) * 2 + hi) * 32 + 8 * fq) * 8 + j;
                        const unsigned p0 = cvt_pk_bf16(a[0], a[1]), p1 = cvt_pk_bf16(a[2], a[3]), p2 = cvt_pk_bf16(c[0], c[1]), p3 = cvt_pk_bf16(c[2], c[3]);
                        vp[0] = (bf16_t)p0; vp[8] = (bf16_t)(p0 >> 16); vp[16] = (bf16_t)p1; vp[24] = (bf16_t)(p1 >> 16);
                        vp[32] = (bf16_t)p2; vp[40] = (bf16_t)(p2 >> 16); vp[48] = (bf16_t)p3; vp[56] = (bf16_t)(p3 >> 16);
                    }
                }
                asm volatile("" ::: "memory");
            }
    }
};
struct EpiG1b {
    static constexpr bool APERM = false;
    bf16_t *OA; const bf16_t* OB; const float* bg;
    __device__ __forceinline__ void operator()(AccRef acc, const Unit& u, int wr, int wc, int fr, int fq) const {
        asm volatile("" : "+v"(fr), "+v"(fq));
        const int c0 = u.pn * 128 + wc * 32 + 8 * fq;
        f32x4 ba[2], bb[2];
#pragma unroll
        for (int n = 0; n < 2; ++n) { ba[n] = *(const f32x4*)(bg + c0 + 4 * n); bb[n] = *(const f32x4*)(bg + DM + c0 + 4 * n); }
#pragma unroll
        for (int ai = 0; ai < 2; ++ai)
#pragma unroll
            for (int m = 0; m < 4; ++m) {
                const size_t off = ((size_t)u.pm * 256 + ai * 128 + wr * 64 + m * 16 + fr) * DM + c0;
                const u32x4 oa = *(const u32x4*)(OA + off), ob = *(const u32x4*)(OB + off);
                float r[8];
#pragma unroll
                for (int n = 0; n < 2; ++n)
#pragma unroll
                    for (int e = 0; e < 4; ++e) {
                        const int j = 4 * n + e; const unsigned wa = oa[j >> 1], wb = ob[j >> 1];
                        const float fa = (j & 1) ? __builtin_bit_cast(float, wa & 0xffff0000u) : __builtin_bit_cast(float, wa << 16);
                        const float fb = (j & 1) ? __builtin_bit_cast(float, wb & 0xffff0000u) : __builtin_bit_cast(float, wb << 16);
                                r[j] = sigmoidf_(acc[ai][0][m][n][e] + ba[n][e]) * fa + sigmoidf_(acc[ai][1][m][n][e] + bb[n][e]) * fb;
                    }
                u32x4 w; w.x = cvt_pk_bf16(r[0], r[1]); w.y = cvt_pk_bf16(r[2], r[3]); w.z = cvt_pk_bf16(r[4], r[5]); w.w = cvt_pk_bf16(r[6], r[7]);
                *(u32x4*)(OA + off) = w;
                asm volatile("" ::: "memory");
            }
    }
};
struct EpiRes {
    static constexpr bool APERM = false;
    const float* xin_p; float* xout; float* part;
    __device__ __forceinline__ void operator()(AccRef acc, const Unit& u, int wr, int wc, int fr, int fq) const {
        asm volatile("" : "+v"(fr), "+v"(fq));
        float* ob = xout + (size_t)u.pm * 256 * DM;
        if (u.pm == 64) {
            float* pb = part + (size_t)(u.k0 / u.nt) * MS * DM;
#pragma unroll
            for (int ai = 0; ai < 2; ++ai)
#pragma unroll
                for (int m = 0; m < 4; ++m) {
                    const size_t off = (size_t)(ai * 128 + wr * 64 + m * 16 + fr) * DM + u.pn * 256 + wc * 32 + 8 * fq;
#pragma unroll
                    for (int bj = 0; bj < 2; ++bj)
#pragma unroll
                        for (int n = 0; n < 2; ++n) *(f32x4*)(pb + off + bj * 128 + 4 * n) = acc[ai][bj][m][n];
                }
            return;
        }
        const float* xb = xin_p + (size_t)u.pm * 256 * DM;
#pragma unroll
        for (int ai = 0; ai < 2; ++ai)
#pragma unroll
            for (int m = 0; m < 4; ++m) {
                const size_t off = (size_t)(ai * 128 + wr * 64 + m * 16 + fr) * DM + u.pn * 256 + wc * 32 + 8 * fq;
#pragma unroll
                for (int bj = 0; bj < 2; ++bj)
#pragma unroll
                    for (int n = 0; n < 2; ++n) { const f32x4 x = *(const f32x4*)(xb + off + bj * 128 + 4 * n); *(f32x4*)(ob + off + bj * 128 + 4 * n) = x + acc[ai][bj][m][n]; }
                asm volatile("" ::: "memory");
            }
    }
};
__device__ __forceinline__ float dpp_shr1(float x) { return __builtin_bit_cast(float, __builtin_amdgcn_update_dpp(0, __builtin_bit_cast(int, x), 0x111  , 0xf, 0xf, false)); }
__device__ __forceinline__ f32x4 dpp_prev_lane(f32x4 v) {
    const float a = dpp_shr1(v.x), b = dpp_shr1(v.y), c = dpp_shr1(v.z), d = dpp_shr1(v.w);
    return (f32x4){a, b, c, d};
}
struct EpiG3 {
    static constexpr bool APERM = true;
    unsigned char* ws; float* o_pfc; const float* cw; const float* cb;
    __device__ __forceinline__ void operator()(AccRef acc, const Unit& u, int wr, int wc, int fr, int fq) const {
        asm volatile("" : "+v"(fr), "+v"(fq));
        bf16_t* ACT = (bf16_t*)(ws + WS_ACT); float* HU = (float*)(ws + WS_HU); float* US = (float*)(ws + WS_US);
        const int ca0 = u.pn * 128 + wc * 32 + 8 * fq;
        if (u.pm == 64) {
#pragma unroll
            for (int ai = 0; ai < 2; ++ai)
#pragma unroll
                for (int m = 0; m < 4; ++m) { float* p = US + (size_t)(ai * 128 + wr * 64 + 4 * fr + m) * NUP + ca0;
#pragma unroll
                    for (int bj = 0; bj < 2; ++bj)
#pragma unroll
                        for (int n = 0; n < 2; ++n) *(f32x4*)(p + bj * DFF + 4 * n) = acc[ai][bj][m][n]; }
            return;
        }
#pragma unroll
        for (int ai = 0; ai < 2; ++ai) {
            const int seg = u.pm * 4 + ai * 2 + wr;
            const size_t row0 = (size_t)u.pm * 256 + ai * 128 + wr * 64 + 4 * fr;
            const bool lastseg = ((u.pm & 15) == 15) && ai == 1 && wr == 1;
#pragma unroll
            for (int n = 0; n < 2; ++n) {
                f32x4 cg[4];
#pragma unroll
                for (int bj = 1; bj >= 0; --bj) {
                    const int col = bj * DFF + ca0 + 4 * n;
                    const f32x4 w0 = *(const f32x4*)(cw + col), w1 = *(const f32x4*)(cw + NUP + col), w2 = *(const f32x4*)(cw + 2 * NUP + col), bb = *(const f32x4*)(cb + col);
                    const f32x4 x0 = acc[ai][bj][0][n], x1 = acc[ai][bj][1][n], x2 = acc[ai][bj][2][n], x3 = acc[ai][bj][3][n];
                    const f32x4 p1 = dpp_prev_lane(x3), p2 = dpp_prev_lane(x2);
                    if (fr == 0) { float* h = HU + (size_t)seg * 4 * NUP + col; *(f32x4*)h = x0; *(f32x4*)(h + NUP) = x1; }
                    if (fr == 15) { float* h = HU + (size_t)seg * 4 * NUP + 2 * NUP + col; *(f32x4*)h = x2; *(f32x4*)(h + NUP) = x3;
                        if (lastseg) { float* o = o_pfc + (size_t)(u.pm >> 4) * 2 * NUP + col; *(f32x4*)o = x2; *(f32x4*)(o + NUP) = x3; } }
                    f32x4 c[4];
                    c[0] = bb + w0 * p2 + w1 * p1 + w2 * x0;
                    c[1] = bb + w0 * p1 + w1 * x0 + w2 * x1;
                    c[2] = bb + w0 * x0 + w1 * x1 + w2 * x2;
                    c[3] = bb + w0 * x1 + w1 * x2 + w2 * x3;
                    if (bj == 1) {
#pragma unroll
                        for (int m = 0; m < 4; ++m) cg[m] = c[m];
                    } else {
#pragma unroll
                        for (int m = 0; m < 4; ++m) {
                            const float a0 = gelu1(c[m][0]) * cg[m][0], a1 = gelu1(c[m][1]) * cg[m][1], a2 = gelu1(c[m][2]) * cg[m][2], a3 = gelu1(c[m][3]) * cg[m][3];
                            u32x2 w; w.x = cvt_pk_bf16(a0, a1); w.y = cvt_pk_bf16(a2, a3);
                            *(u32x2*)(ACT + (row0 + m) * DFF + ca0 + 4 * n) = w;
                        }
                    }
                }
                asm volatile("" ::: "memory");
            }
        }
    }
};

__device__ __forceinline__ float wave_sum(float v) {
#pragma unroll
    for (int o = 1; o < 64; o <<= 1) v += __shfl_xor(v, o);
    return v;
}
__device__ __forceinline__ void transpose_item(const float* W, int K, int Nsrc, bf16_t* WT, int kb, int nb, int sb, LAS float* scr, int lane) {
    const int k0 = 64 * kb, n0 = 32 * nb, s0 = 32 * sb;
#pragma unroll 8
    for (int i = 0; i < 32; ++i) { const int kk = 2 * i + (lane >> 5); scr[kk * 33 + (lane & 31)] = W[(size_t)(k0 + kk) * Nsrc + s0 + (lane & 31)]; }
    asm volatile("s_waitcnt lgkmcnt(0)" ::: "memory");
    const int c = lane & 7;
#pragma unroll
    for (int j = 0; j < 4; ++j) { const int n = (lane >> 3) + 8 * j; const LAS float* s = scr + (8 * c) * 33 + n;
        u32x4 o; o.x = cvt_pk_bf16(s[0 * 33], s[1 * 33]); o.y = cvt_pk_bf16(s[2 * 33], s[3 * 33]); o.z = cvt_pk_bf16(s[4 * 33], s[5 * 33]); o.w = cvt_pk_bf16(s[6 * 33], s[7 * 33]);
        *(u32x4*)(WT + (size_t)(n0 + n) * K + k0 + 8 * c) = o; }
    asm volatile("s_waitcnt lgkmcnt(0)" ::: "memory");
}
__device__ __forceinline__ int win_srcblk(int nb) {
    const int pn = nb >> 3, sb = nb & 7, bj = sb >> 2, wc = sb & 3;
    if (pn < 18) return 8 * pn + 2 * wc + bj;
    return 144 + 32 * bj + 4 * (pn - 18) + wc;
}
__device__ __forceinline__ int wup_srcblk(int nb) { const int pn = nb >> 3, sb = nb & 7, bj = sb >> 2; return 88 * bj + 4 * pn + (sb & 3); }

__device__ __forceinline__ void norm_row(const float* xrow, const float* g, bf16_t* orow, int lane, const float* part = nullptr, int nparts = 0, float* xw = nullptr) {
    const f32x4* xr = (const f32x4*)xrow + lane; const f32x4* gr = (const f32x4*)g + lane;
    f32x4 v[4]; float s = 0.f;
#pragma unroll
    for (int j = 0; j < 4; ++j) v[j] = xr[64 * j];
    if (nparts > 0) {
        typedef const __attribute__((address_space(1))) f32x4* gv4;
        int p = 0;
        for (; p + 4 <= nparts; p += 4) { f32x4 t[4][4];
#pragma unroll
            for (int q = 0; q < 4; ++q)
#pragma unroll
                for (int j = 0; j < 4; ++j) t[q][j] = *((gv4)(part + (size_t)(p + q) * MS * DM) + lane + 64 * j);
#pragma unroll
            for (int j = 0; j < 4; ++j) v[j] += (t[0][j] + t[1][j]) + (t[2][j] + t[3][j]); }
        for (; p < nparts; ++p) { const f32x4* pr = (const f32x4*)(part + (size_t)p * MS * DM) + lane;
#pragma unroll
            for (int j = 0; j < 4; ++j) v[j] += pr[64 * j]; }
        f32x4* wr_ = (f32x4*)xw + lane;
#pragma unroll
        for (int j = 0; j < 4; ++j) wr_[64 * j] = v[j];
    }
#pragma unroll
    for (int j = 0; j < 4; ++j) s += (v[j].x * v[j].x + v[j].y * v[j].y) + (v[j].z * v[j].z + v[j].w * v[j].w);
    const float rstd = __builtin_amdgcn_rsqf(wave_sum(s) * (1.f / DM) + EPS);
    u32x2* o8 = (u32x2*)orow + lane;
#pragma unroll
    for (int j = 0; j < 4; ++j) { const f32x4 gg = gr[64 * j]; u32x2 w; w.x = cvt_pk_bf16(v[j].x * rstd * gg.x, v[j].y * rstd * gg.y); w.y = cvt_pk_bf16(v[j].z * rstd * gg.z, v[j].w * rstd * gg.w); o8[64 * j] = w; }
}
__device__ __forceinline__ void norm_rows(const float* x, const float* g, bf16_t* XN, int gw, int NGW, int lane) {
    typedef const __attribute__((address_space(1))) f32x4* gv4;
    const f32x4* gr = (const f32x4*)g + lane;
    f32x4 gg[4];
#pragma unroll
    for (int j = 0; j < 4; ++j) gg[j] = gr[64 * j];
    int m = gw; if (m >= MP) return;
    f32x4 vn[4];
#pragma unroll
    for (int j = 0; j < 4; ++j) vn[j] = __builtin_nontemporal_load((gv4)(x + (size_t)m * DM) + lane + 64 * j);
    for (; m < MP; m += NGW) {
        f32x4 v[4];
#pragma unroll
        for (int j = 0; j < 4; ++j) v[j] = vn[j];
        const int mn = m + NGW;
        if (mn < MP) {
#pragma unroll
            for (int j = 0; j < 4; ++j) vn[j] = __builtin_nontemporal_load((gv4)(x + (size_t)mn * DM) + lane + 64 * j);
        }
        float sq = 0.f;
#pragma unroll
        for (int j = 0; j < 4; ++j) sq += (v[j].x * v[j].x + v[j].y * v[j].y) + (v[j].z * v[j].z + v[j].w * v[j].w);
        const float rstd = __builtin_amdgcn_rsqf(wave_sum(sq) * (1.f / DM) + EPS);
        __attribute__((address_space(1))) u32x2* o8 = (__attribute__((address_space(1))) u32x2*)(XN + (size_t)m * DM) + lane;
#pragma unroll
        for (int j = 0; j < 4; ++j) { u32x2 w; w.x = cvt_pk_bf16(v[j].x * rstd * gg[j].x, v[j].y * rstd * gg[j].y); w.y = cvt_pk_bf16(v[j].z * rstd * gg[j].z, v[j].w * rstd * gg[j].w); o8[64 * j] = w; }
    }
}
__device__ __forceinline__ void cache_convert(const float* ck, const float* cv, bf16_t* KS, bf16_t* VS, int W, int H, int NBS, int gtid, int gthreads) {
    const int nchunk = SBATCH * H * (W / 32) * 256;
    for (int id = gtid; id < 2 * nchunk; id += gthreads) {
        const bool isv = id >= nchunk; int c = isv ? id - nchunk : id;
        const int within = c & 255; c >>= 8; const int blk = c % (W / 32); c /= (W / 32); const int h = c % H, b = c / H;
        u32x4 w;
        if (!isv) { const int key = within & 31, hi = (within >> 5) & 1, d0 = within >> 6;
            const float* src = ck + ((size_t)(b * W + blk * 32 + key) * H + h) * 64 + 32 * hi + 8 * d0;
            const f32x4 a = *(const f32x4*)src, bb = *(const f32x4*)(src + 4);
            w.x = cvt_pk_bf16(a[0], a[1]); w.y = cvt_pk_bf16(a[2], a[3]); w.z = cvt_pk_bf16(bb[0], bb[1]); w.w = cvt_pk_bf16(bb[2], bb[3]);
            *(u32x4*)(KS + ((size_t)(b * H + h) * NBS + blk) * 2048 + within * 8) = w;
        } else { const int dl = within & 31, hi = (within >> 5) & 1, dblk = (within >> 6) & 1, s = within >> 7;
            float f[8];
#pragma unroll
            for (int j = 0; j < 8; ++j) { const int key = 16 * s + 4 * hi + (j & 3) + 8 * (j >> 2); f[j] = cv[((size_t)(b * W + blk * 32 + key) * H + h) * 64 + 32 * dblk + dl]; }
            w.x = cvt_pk_bf16(f[0], f[1]); w.y = cvt_pk_bf16(f[2], f[3]); w.z = cvt_pk_bf16(f[4], f[5]); w.w = cvt_pk_bf16(f[6], f[7]);
            *(u32x4*)(VS + ((size_t)(b * H + h) * NBS + blk) * 2048 + within * 8) = w;
        }
    }
}
struct TItem { const float* src; bf16_t* dst; int K; int Nsrc; };
__device__ __forceinline__ void t_load(f32x4 (&v)[8], const TItem& t, int lane) {
    const float* p = t.src + (size_t)(lane >> 3) * t.Nsrc + 4 * (lane & 7);
#pragma unroll
    for (int i = 0; i < 8; ++i) v[i] = *(const __attribute__((address_space(1))) f32x4*)(p + (size_t)(8 * i) * t.Nsrc);
}
__device__ __forceinline__ void t_store(const f32x4 (&v)[8], const TItem& t, LAS float* scr, int lane) {
    const int c = lane & 7, r = lane >> 3;
#pragma unroll
    for (int i = 0; i < 8; ++i)
#pragma unroll
        for (int e = 0; e < 4; ++e) scr[(4 * c + e) * 65 + r + 8 * i] = v[i][e];
    asm volatile("s_waitcnt lgkmcnt(0)" ::: "memory");
#pragma unroll
    for (int j = 0; j < 4; ++j) { const int n = r + 8 * j; const LAS float* sp = scr + n * 65 + 8 * c;
        u32x4 o; o.x = cvt_pk_bf16(sp[0], sp[1]); o.y = cvt_pk_bf16(sp[2], sp[3]); o.z = cvt_pk_bf16(sp[4], sp[5]); o.w = cvt_pk_bf16(sp[6], sp[7]);
        *(__attribute__((address_space(1))) u32x4*)(t.dst + (size_t)n * t.K + 8 * c) = o; }
    asm volatile("s_waitcnt lgkmcnt(0)" ::: "memory");
}
__device__ __forceinline__ TItem t_decode(const Params& P, unsigned char* ws, int l, int pair, int it) {
    constexpr int I_IN = 16 * (NIN / 32), I_UP = 16 * (NUP / 32);
    TItem t;
    if (pair == 0) {
        if (it < I_IN) { const int nb = it % (NIN / 32), kb = it / (NIN / 32); t.K = DM; t.Nsrc = NIN; t.src = P.in[8] + (size_t)l * DM * NIN + (size_t)(64 * kb) * NIN + 32 * win_srcblk(nb); t.dst = (bf16_t*)(ws + WS_WIN) + (size_t)(32 * nb) * DM + 64 * kb; }
        else { const int r = it - I_IN, nb = r % 32, kb = r / 32; t.K = DM; t.Nsrc = DM; t.src = P.in[16] + (size_t)l * DM * DM + (size_t)(64 * kb) * DM + 32 * nb; t.dst = (bf16_t*)(ws + WS_WOUT) + (size_t)(32 * nb) * DM + 64 * kb; }
    } else {
        if (it < I_UP) { const int nb = it % (NUP / 32), kb = it / (NUP / 32); t.K = DM; t.Nsrc = NUP; t.src = P.in[18] + (size_t)l * DM * NUP + (size_t)(64 * kb) * NUP + 32 * wup_srcblk(nb); t.dst = (bf16_t*)(ws + WS_WUP) + (size_t)(32 * nb) * DM + 64 * kb; }
        else { const int r = it - I_UP, nb = r % 32, kb = r / 32; t.K = DFF; t.Nsrc = DM; t.src = P.in[21] + (size_t)l * DFF * DM + (size_t)(64 * kb) * DM + 32 * nb; t.dst = (bf16_t*)(ws + WS_WDN) + (size_t)(32 * nb) * DFF + 64 * kb; }
    }
    return t;
}
__device__ __forceinline__ void weight_items(const Params& P, int l, int pair, LAS unsigned char* lds, int widx, int nw, int wave_s, int lo_pm = 0, int hi_pm = 1000) {
    int tid_ = phase_tid(wave_s);
    const int lane = tid_ & 63, wave = tid_ >> 6;
    LAS float* scr = (LAS float*)(lds + wave * 16384);
    unsigned char* ws = P.ws; asm volatile("" : "+s"(ws));
    constexpr int I_IN = 16 * (NIN / 32), I_OUT = 16 * (DM / 32), I_UP = 16 * (NUP / 32), I_DN = (DFF / 64) * (DM / 32);
    const int NT = pair == 0 ? I_IN + I_OUT : I_UP + I_DN;
    const int N = (int)((long)NT * hi_pm / 1000);
    int it = (int)((long)NT * lo_pm / 1000) + widx; if (it >= N) return;
    f32x4 va[8], vb[8], vc[8];
    TItem ta = t_decode(P, ws, l, pair, it), tb = ta, tc = ta;
    t_load(va, ta, lane);
    if (it + nw < N) { tb = t_decode(P, ws, l, pair, it + nw); t_load(vb, tb, lane); }
    for (;;) {
        if (it + 2 * nw < N) { tc = t_decode(P, ws, l, pair, it + 2 * nw); t_load(vc, tc, lane); }
        t_store(va, ta, scr, lane);
        if (it + nw >= N) break;
        if (it + 3 * nw < N) { ta = t_decode(P, ws, l, pair, it + 3 * nw); t_load(va, ta, lane); }
        t_store(vb, tb, scr, lane);
        if (it + 2 * nw >= N) break;
        if (it + 4 * nw < N) { tb = t_decode(P, ws, l, pair, it + 4 * nw); t_load(vb, tb, lane); }
        t_store(vc, tc, scr, lane);
        if (it + 3 * nw >= N) break;
        it += 3 * nw;
    }
}
__device__ __forceinline__ void pre_phase(const Params& P, int l, LAS unsigned char* lds, int vcu, int G, const float* xp, const float* xs, int wave_s) {
    int tid_ = phase_tid(wave_s);
    const int tid = tid_, lane = tid & 63, wave = tid >> 6;
    const int gw = vcu * 8 + wave, NGW = G * 8;
    unsigned char* ws = P.ws; asm volatile("" : "+s"(ws));
    if (l == 0) weight_items(P, 0, 0, lds, gw, NGW, wave_s);
    else weight_items(P, l, 0, lds, gw, NGW, wave_s, 550, 1000);
    const int gtid = vcu * 512 + tid, gthreads = G * 512;
    cache_convert(P.in[2] + (size_t)l * SBATCH * 128 * 4 * 64, P.in[3] + (size_t)l * SBATCH * 128 * 4 * 64, (bf16_t*)(ws + WS_KAS), (bf16_t*)(ws + WS_VAS), 128, 4, NBS_A, gtid, gthreads);
    cache_convert(P.in[4] + (size_t)l * SBATCH * 512 * 16 * 64, P.in[5] + (size_t)l * SBATCH * 512 * 16 * 64, (bf16_t*)(ws + WS_KBS), (bf16_t*)(ws + WS_VBS), 512, 16, NBS_B, gtid, gthreads);
    if (l == 0) { const f32x4* src = (const f32x4*)xs; f32x4* dst = (f32x4*)(P.out + (size_t)MP * DM);
        for (int i = gtid; i < MS * DM / 4; i += gthreads) dst[i] = src[i]; }
    const float* g1 = P.in[7] + (size_t)l * DM; bf16_t* XN = (bf16_t*)(ws + WS_XN);
    norm_rows(xp, g1, XN, gw, NGW, lane);
    for (int m = MP + gw; m < MT; m += NGW) {
        if (l == 0) norm_row(xs + (size_t)(m - MP) * DM, g1, XN + (size_t)m * DM, lane);
        else { float* yr = P.out + (size_t)m * DM; norm_row(yr, g1, XN + (size_t)m * DM, lane, (const float*)(ws + WS_PART) + (size_t)(m - MP) * DM, 11, yr); }
    }
}
__device__ __forceinline__ void norm2_phase(const Params& P, int l, int vcu, int G, int wave_s) {
    int tid_ = phase_tid(wave_s);
    const int tid = tid_, lane = tid & 63, wave = tid >> 6; const int gw = vcu * 8 + wave, NGW = G * 8;
    unsigned char* ws = P.ws; const float* x = P.out; asm volatile("" : "+s"(ws), "+s"(x));
    const float* g2 = P.in[17] + (size_t)l * DM; bf16_t* XN = (bf16_t*)(ws + WS_XN);
    norm_rows(x, g2, XN, gw, NGW, lane);
    for (int m = MP + gw; m < MT; m += NGW) {
        { float* yr = P.out + (size_t)m * DM; norm_row(yr, g2, XN + (size_t)m * DM, lane, (const float*)(ws + WS_PART) + (size_t)(m - MP) * DM, 8, yr); }
    }
}
__device__ __forceinline__ void fix_phase(const Params& P, int l, int vcu, int G, int wave_s) {
    int tid_ = phase_tid(wave_s);
    const int gtid = vcu * 512 + tid_, gthreads = G * 512;
    unsigned char* ws = P.ws; asm volatile("" : "+s"(ws));
    const float* cw = P.in[19] + (size_t)l * 3 * NUP; const float* cb = P.in[20] + (size_t)l * NUP;
    const float* HU = (const float*)(ws + WS_HU); const float* US = (const float*)(ws + WS_US); bf16_t* ACT = (bf16_t*)(ws + WS_ACT);
    const float* cprev = P.in[6] + (size_t)l * SBATCH * 2 * NUP;
    float* o_sfc = P.out + O_SFC + (size_t)l * SBATCH * 2 * NUP;
    constexpr int DF4 = DFF / 4, NPF = 256 * 2 * DF4, NSF = 256 * DF4, NSC = SBATCH * 2 * NUP / 4;
    for (int id = gtid; id < NPF + NSF + NSC; id += gthreads) {
        if (id < NPF) {
            const int j = (id % DF4) * 4, rr = (id / DF4) & 1, seg = id / (2 * DF4);
            f32x4 c2[2];
#pragma unroll
            for (int bj = 0; bj < 2; ++bj) { const int col = bj * DFF + j;
                const float* h = HU + (size_t)seg * 4 * NUP + col; const float* hp = HU + (size_t)(seg - 1) * 4 * NUP + col;
                const bool first = (seg & 63) == 0; const f32x4 z = {0.f, 0.f, 0.f, 0.f};
                const f32x4 p62 = first ? z : *(const f32x4*)(hp + 2 * NUP), p63 = first ? z : *(const f32x4*)(hp + 3 * NUP), x0 = *(const f32x4*)h, x1 = *(const f32x4*)(h + NUP);
                const f32x4 w0 = *(const f32x4*)(cw + col), w1 = *(const f32x4*)(cw + NUP + col), w2 = *(const f32x4*)(cw + 2 * NUP + col), bb = *(const f32x4*)(cb + col);
                c2[bj] = rr == 0 ? bb + w0 * p62 + w1 * p63 + w2 * x0 : bb + w0 * p63 + w1 * x0 + w2 * x1; }
            u32x2 w; w.x = cvt_pk_bf16(gelu1(c2[0][0]) * c2[1][0], gelu1(c2[0][1]) * c2[1][1]); w.y = cvt_pk_bf16(gelu1(c2[0][2]) * c2[1][2], gelu1(c2[0][3]) * c2[1][3]);
            *(u32x2*)(ACT + (size_t)(seg * 64 + rr) * DFF + j) = w;
        } else if (id < NPF + NSF) {
            const int r = id - NPF; const int j = (r % DF4) * 4, row = r / DF4, b = row >> 5, t = row & 31;
            f32x4 c2[2];
#pragma unroll
            for (int bj = 0; bj < 2; ++bj) { const int col = bj * DFF + j;
                const f32x4 xm2 = *(const f32x4*)(t >= 2 ? US + (size_t)(row - 2) * NUP + col : cprev + (size_t)(b * 2 + t) * NUP + col);
                const f32x4 xm1 = *(const f32x4*)(t >= 1 ? US + (size_t)(row - 1) * NUP + col : cprev + (size_t)(b * 2 + 1) * NUP + col);
                const f32x4 x0 = *(const f32x4*)(US + (size_t)row * NUP + col);
                c2[bj] = *(const f32x4*)(cb + col) + *(const f32x4*)(cw + col) * xm2 + *(const f32x4*)(cw + NUP + col) * xm1 + *(const f32x4*)(cw + 2 * NUP + col) * x0; }
            u32x2 w; w.x = cvt_pk_bf16(gelu1(c2[0][0]) * c2[1][0], gelu1(c2[0][1]) * c2[1][1]); w.y = cvt_pk_bf16(gelu1(c2[0][2]) * c2[1][2], gelu1(c2[0][3]) * c2[1][3]);
            *(u32x2*)(ACT + (size_t)(MP + row) * DFF + j) = w;
        } else {
            const int r = (id - NPF - NSF) * 4; const int col = r % NUP, k = (r / NUP) & 1, b = r / (2 * NUP);
            *(f32x4*)(o_sfc + r) = *(const f32x4*)(US + (size_t)(b * 32 + 30 + k) * NUP + col);
        }
    }
}

template <int NQB, bool MIXB>
__device__ __forceinline__ void attn_item(bf16_t* Qp, const bf16_t* Kb, const bf16_t* Vb, int kb0, int kb1, int qpos0, float slope_l2, float sink_l2, const LAS float* tbl, int lane) {
    typedef const __attribute__((address_space(1))) bf16x8* gfrag;
    const int r32 = lane & 31, hi = lane >> 5;
    bf16x8 qf[NQB][4];
#pragma unroll
    for (int qb = 0; qb < NQB; ++qb)
#pragma unroll
        for (int d0 = 0; d0 < 4; ++d0) qf[qb][d0] = *(gfrag)(Qp + (size_t)(32 * qb + r32) * DM + 32 * hi + 8 * d0);
    f32x16 o[NQB][2]; float mrun[NQB], lrun[NQB];
#pragma unroll
    for (int qb = 0; qb < NQB; ++qb) { mrun[qb] = -1e30f; lrun[qb] = 0.f;
#pragma unroll
        for (int d = 0; d < 2; ++d)
#pragma unroll
            for (int r = 0; r < 16; ++r) o[qb][d][r] = 0.f; }
    const float SC = 0.125f * LOG2E;
    const float cfar = MIXB ? tbl[256] : 0.f;
    const bf16_t* kp = Kb + (size_t)kb0 * 2048 + hi * 256 + r32 * 8;
    const bf16_t* vp = Vb + (size_t)kb0 * 2048 + hi * 256 + r32 * 8;
    bf16x8 kf[4], vf[4];
    f32x16 sc[NQB], sn[NQB];
#pragma unroll
    for (int i = 0; i < 4; ++i) kf[i] = *(gfrag)(kp + i * 512);
#pragma unroll
    for (int qb = 0; qb < NQB; ++qb) {
#pragma unroll
        for (int r = 0; r < 16; ++r) sc[qb][r] = 0.f;
#pragma unroll
        for (int d0 = 0; d0 < 4; ++d0) sc[qb] = __builtin_amdgcn_mfma_f32_32x32x16_bf16(kf[d0], qf[qb][d0], sc[qb], 0, 0, 0);
    }
    kp += 2048;
    if (kb0 + 1 < kb1) {
#pragma unroll
        for (int i = 0; i < 4; ++i) kf[i] = *(gfrag)(kp + i * 512);
    }
    for (int kb = kb0; kb < kb1; ++kb) {
#pragma unroll
        for (int i = 0; i < 4; ++i) vf[i] = *(gfrag)(vp + i * 512);
        vp += 2048;
        if (kb + 1 < kb1) {
#pragma unroll
            for (int qb = 0; qb < NQB; ++qb) {
#pragma unroll
                for (int r = 0; r < 16; ++r) sn[qb][r] = 0.f;
#pragma unroll
                for (int d0 = 0; d0 < 4; ++d0) sn[qb] = __builtin_amdgcn_mfma_f32_32x32x16_bf16(kf[d0], qf[qb][d0], sn[qb], 0, 0, 0);
            }
            kp += 2048;
            if (kb + 2 < kb1) {
#pragma unroll
                for (int i = 0; i < 4; ++i) kf[i] = *(gfrag)(kp + i * 512);
            }
        }
        const bool far = MIXB && (qpos0 - (kb * 32 + 31) >= 128);
#pragma unroll
        for (int qb = 0; qb < NQB; ++qb) {
            f32x16 s = sc[qb];
            const int dbase = qpos0 + 32 * qb + r32 - kb * 32 - 4 * hi;
            float mx = -1e30f;
            if (far) {
#pragma unroll
                for (int r = 0; r < 16; ++r) { float t = __builtin_fmaf(s[r], SC, cfar); asm("" : "+v"(t)); s[r] = t; mx = __builtin_fmaxf(mx, t); }
            } else {
#pragma unroll
                for (int r = 0; r < 16; ++r) {
                    const int dist = dbase - ((r & 3) + 8 * (r >> 2));
                    float bias;
                    if (MIXB) { int idx = dist < -128 ? -128 : dist; idx = idx > 128 ? 128 : idx; bias = tbl[idx + 128]; }
                    else bias = -slope_l2 * __builtin_fabsf((float)dist);
                    float t = __builtin_fmaf(s[r], SC, bias); asm("" : "+v"(t)); s[r] = t; mx = __builtin_fmaxf(mx, t);
                }
            }
            mx = __builtin_fmaxf(mx, __shfl_xor(mx, 32));
            const float mold = mrun[qb];
            const bool grow = __builtin_amdgcn_ballot_w64(mx > mold + 6.0f) != 0;
            const float mnew = grow ? __builtin_fmaxf(mold, mx) : mold;
            mrun[qb] = mnew;
            float ls = 0.f;
#pragma unroll
            for (int r = 0; r < 16; ++r) { s[r] = __builtin_amdgcn_exp2f(s[r] - mnew); ls += s[r]; }
            if (grow) {
                const float alpha = __builtin_amdgcn_exp2f(mold - mnew);
                lrun[qb] *= alpha;
#pragma unroll
                for (int d = 0; d < 2; ++d)
#pragma unroll
                    for (int r = 0; r < 16; ++r) o[qb][d][r] *= alpha;
            }
            lrun[qb] += ls;
            u32x4 p0, p1;
            p0.x = cvt_pk_bf16(s[0], s[1]); p0.y = cvt_pk_bf16(s[2], s[3]); p0.z = cvt_pk_bf16(s[4], s[5]); p0.w = cvt_pk_bf16(s[6], s[7]);
            p1.x = cvt_pk_bf16(s[8], s[9]); p1.y = cvt_pk_bf16(s[10], s[11]); p1.z = cvt_pk_bf16(s[12], s[13]); p1.w = cvt_pk_bf16(s[14], s[15]);
            const bf16x8 pf0 = __builtin_bit_cast(bf16x8, p0), pf1 = __builtin_bit_cast(bf16x8, p1);
            o[qb][0] = __builtin_amdgcn_mfma_f32_32x32x16_bf16(vf[0], pf0, o[qb][0], 0, 0, 0);
            o[qb][1] = __builtin_amdgcn_mfma_f32_32x32x16_bf16(vf[1], pf0, o[qb][1], 0, 0, 0);
            o[qb][0] = __builtin_amdgcn_mfma_f32_32x32x16_bf16(vf[2], pf1, o[qb][0], 0, 0, 0);
            o[qb][1] = __builtin_amdgcn_mfma_f32_32x32x16_bf16(vf[3], pf1, o[qb][1], 0, 0, 0);
        }
#pragma unroll
        for (int qb = 0; qb < NQB; ++qb) sc[qb] = sn[qb];
    }
#pragma unroll
    for (int qb = 0; qb < NQB; ++qb) {
        float lt = lrun[qb] + __shfl_xor(lrun[qb], 32);
        if (!MIXB) lt += __builtin_amdgcn_exp2f(sink_l2 - mrun[qb]);
        const float inv = 1.0f / lt;
        bf16_t* op = Qp + (size_t)(32 * qb + r32) * DM + 4 * hi;
#pragma unroll
        for (int d = 0; d < 2; ++d)
#pragma unroll
            for (int g = 0; g < 4; ++g) { u32x2 w; w.x = cvt_pk_bf16(o[qb][d][4 * g] * inv, o[qb][d][4 * g + 1] * inv); w.y = cvt_pk_bf16(o[qb][d][4 * g + 2] * inv, o[qb][d][4 * g + 3] * inv);
                *(__attribute__((address_space(1))) u32x2*)(op + 32 * d + 8 * g) = w; }
    }
}
__device__ __forceinline__ void attn_phase(const Params& P, int l, LAS unsigned char* lds, int vcu, int G, int wave_s) {
    int tid_ = phase_tid(wave_s);
    const int tid = tid_, lane = tid & 63, wave = __builtin_amdgcn_readfirstlane(tid >> 6);
    LAS float* tbl = (LAS float*)(lds + wave * 2048);
    unsigned char* ws = P.ws; asm volatile("" : "+s"(ws));
    bf16_t* QA = (bf16_t*)(ws + WS_QA); bf16_t* QB = (bf16_t*)(ws + WS_QB);
    const float* sinks = P.in[14] + l * 16; const float* rel = P.in[15] + (size_t)l * 257 * 16;
    const int gw = vcu * 8 + wave, NGW = G * 8;
    int cur_h = -1;
    for (int id = gw; id < NBATCH * 16 * 64; id += NGW) {
        const int c = id & 63, h = (id >> 6) & 15, b = id >> 10;
        if (h != cur_h) { for (int i = lane; i < 257; i += 64) tbl[i] = rel[i * 16 + h] * LOG2E; cur_h = h; asm volatile("s_waitcnt lgkmcnt(0)" ::: "memory"); }
        const int kb0 = c >= 8 ? 2 * (c - 8) : 0;
        attn_item<2, true>(QB + ((size_t)b * SEQ + c * 64) * DM + h * 64, (const bf16_t*)(ws + WS_KB) + (size_t)(b * 16 + h) * NT32 * 2048, (const bf16_t*)(ws + WS_VB) + (size_t)(b * 16 + h) * NT32 * 2048,
                           kb0, 2 * (c + 1), 64 * c, 0.f, 0.f, tbl, lane);
    }
    for (int id = gw; id < NBATCH * 16 * 64; id += NGW) {
        const int c = id & 63, h = (id >> 6) & 15, b = id >> 10;
        const int kb0 = c >= 2 ? 2 * (c - 2) : 0;
        const float slope = __builtin_amdgcn_exp2f(-0.5f * (float)(h + 1)) * LOG2E;
        attn_item<2, false>(QA + ((size_t)b * SEQ + c * 64) * DM + h * 64, (const bf16_t*)(ws + WS_KA) + (size_t)(b * 4 + (h >> 2)) * NT32 * 2048, (const bf16_t*)(ws + WS_VA) + (size_t)(b * 4 + (h >> 2)) * NT32 * 2048,
                            kb0, 2 * (c + 1), 64 * c, slope, sinks[h] * LOG2E, tbl, lane);
    }
    if (NGW == 2048 && (gw & 63) < 8) {
        const int cs = gw & 63, j = gw >> 6, idx = (cs & 3) * 32 + j, h = idx & 15, b = idx >> 4;
        if (cs < 4) {
            if (h != cur_h) { for (int i = lane; i < 257; i += 64) tbl[i] = rel[i * 16 + h] * LOG2E; cur_h = h; asm volatile("s_waitcnt lgkmcnt(0)" ::: "memory"); }
            attn_item<1, true>(QB + ((size_t)MP + b * STOK) * DM + h * 64, (const bf16_t*)(ws + WS_KBS) + (size_t)(b * 16 + h) * NBS_B * 2048, (const bf16_t*)(ws + WS_VBS) + (size_t)(b * 16 + h) * NBS_B * 2048,
                               0, NBS_B, 512, 0.f, 0.f, tbl, lane);
        } else {
            const float slope = __builtin_amdgcn_exp2f(-0.5f * (float)(h + 1)) * LOG2E;
            attn_item<1, false>(QA + ((size_t)MP + b * STOK) * DM + h * 64, (const bf16_t*)(ws + WS_KAS) + (size_t)(b * 4 + (h >> 2)) * NBS_A * 2048, (const bf16_t*)(ws + WS_VAS) + (size_t)(b * 4 + (h >> 2)) * NBS_A * 2048,
                                0, NBS_A, 128, slope, sinks[h] * LOG2E, tbl, lane);
        }
    } else if (NGW != 2048 && wave == 0) for (int id = vcu; id < 2 * SBATCH * 16; id += G) {
        const int h = id & 15, b = (id >> 4) & 7, mxr = id >> 7;
        if (mxr) {
            if (h != cur_h) { for (int i = lane; i < 257; i += 64) tbl[i] = rel[i * 16 + h] * LOG2E; cur_h = h; asm volatile("s_waitcnt lgkmcnt(0)" ::: "memory"); }
            attn_item<1, true>(QB + ((size_t)MP + b * STOK) * DM + h * 64, (const bf16_t*)(ws + WS_KBS) + (size_t)(b * 16 + h) * NBS_B * 2048, (const bf16_t*)(ws + WS_VBS) + (size_t)(b * 16 + h) * NBS_B * 2048,
                               0, NBS_B, 512, 0.f, 0.f, tbl, lane);
        } else {
            const float slope = __builtin_amdgcn_exp2f(-0.5f * (float)(h + 1)) * LOG2E;
            attn_item<1, false>(QA + ((size_t)MP + b * STOK) * DM + h * 64, (const bf16_t*)(ws + WS_KAS) + (size_t)(b * 4 + (h >> 2)) * NBS_A * 2048, (const bf16_t*)(ws + WS_VAS) + (size_t)(b * 4 + (h >> 2)) * NBS_A * 2048,
                                0, NBS_A, 128, slope, sinks[h] * LOG2E, tbl, lane);
        }
    }
}

#define XB_TMO      128
#define XB_XCNT(j)  (256  + 64 * (j))
#define XB_XSUB(j)  (1280 + 64 * (j))
#define XB_XGEN(j)  (2304 + 64 * (j))
#define XB_TOP      3328
#define XB_TOPGEN   3392
#define XCD_BAR_WORDS 3456
#define XB_SPIN_CAP (1u << 20)
__device__ __forceinline__ unsigned xb_ld(unsigned* p)              { return __hip_atomic_load(p, __ATOMIC_RELAXED, __HIP_MEMORY_SCOPE_AGENT); }
__device__ __forceinline__ unsigned xb_add(unsigned* p, unsigned v) { return __hip_atomic_fetch_add(p, v, __ATOMIC_RELAXED, __HIP_MEMORY_SCOPE_AGENT); }
__device__ __forceinline__ unsigned xb_xcc_id() { return (unsigned)__builtin_amdgcn_s_getreg((3 << 11) | 20) & 0xFu; }
#define XB_SPIN(cond, bar) do { unsigned _sp = 0; while (cond) { __builtin_amdgcn_s_sleep(1); \
    if ((++_sp & 255u) == 0u) { if (xb_ld(&(bar)[XB_TMO])) break; if (_sp > XB_SPIN_CAP) { atomicAdd(&(bar)[XB_TMO], 1u); break; } } } } while (0)
struct XcdBarrier { unsigned* bar; unsigned x; volatile LAS unsigned* st; };
__device__ __forceinline__ void xcd_barrier_complete(unsigned* bar, unsigned x, unsigned& nloc, unsigned& nx) {
    const unsigned G = gridDim.x * gridDim.y * gridDim.z;
    unsigned sum, cnt, mine, sp = 0u;
    for (;;) {
        sum = 0u; cnt = 0u; mine = 0u;
#pragma unroll
        for (unsigned j = 0; j < 16; ++j) { const unsigned c = xb_ld(&bar[XB_XCNT(j)]); sum += c; cnt += (c > 0u) ? 1u : 0u; mine = (j == x) ? c : mine; }
        if (sum == G) break;
        __builtin_amdgcn_s_sleep(1);
        if ((++sp & 255u) == 0u) { if (xb_ld(&bar[XB_TMO])) break; if (sp > XB_SPIN_CAP) { atomicAdd(&bar[XB_TMO], 1u); break; } }
    }
    nloc = mine > 0u ? mine : 1u; nx = cnt > 0u ? cnt : 1u;
}
__device__ __forceinline__ void xcd_barrier(const XcdBarrier& b, int wave_s) {
    asm volatile("s_waitcnt vmcnt(0)" ::: "memory");
    __syncthreads();
    if (wave_s == 0) { int lane; asm volatile("v_mbcnt_lo_u32_b32 %0, -1, 0\n\tv_mbcnt_hi_u32_b32 %0, -1, %0" : "=v"(lane));
    if (lane == 0) {
        unsigned* bar = b.bar;
        __builtin_amdgcn_s_waitcnt(0);
        unsigned nloc = b.st[0], nx = b.st[1];
        if (nloc == 0u) { xcd_barrier_complete(bar, b.x, nloc, nx); b.st[0] = nloc; b.st[1] = nx; }
        const unsigned old = xb_add(&bar[XB_XSUB(b.x)], 1u);
        const unsigned gen = old / nloc;
        if (old + 1u == (gen + 1u) * nloc) {
            __builtin_amdgcn_fence(__ATOMIC_RELEASE, "agent");
            asm volatile("s_waitcnt vmcnt(0)" ::: "memory");
            const unsigned og = xb_add(&bar[XB_TOP], 1u);
            const unsigned tg = og / nx;
            if (og + 1u == (tg + 1u) * nx) xb_add(&bar[XB_TOPGEN], 1u);
            else XB_SPIN(xb_ld(&bar[XB_TOPGEN]) == tg, bar);
            __builtin_amdgcn_fence(__ATOMIC_ACQUIRE, "agent");
            xb_add(&bar[XB_XGEN(b.x)], 1u);
            asm volatile("s_waitcnt vmcnt(0)" ::: "memory");
        } else {
            XB_SPIN(xb_ld(&bar[XB_XGEN(b.x)]) == gen, bar);
            __builtin_amdgcn_fence(__ATOMIC_ACQUIRE, "agent");
            asm volatile("s_waitcnt vmcnt(0)" ::: "memory");
        }
    } }
    __syncthreads();
}
#ifndef PROBE_MASK
#define PROBE_MASK 0u
#endif
#define PH_BEGIN(BIT) unsigned long long _t0_##BIT = 0; if ((PROBE_MASK >> (BIT)) & 1u) _t0_##BIT = __builtin_amdgcn_s_memrealtime();
#define PH_END(BIT) if ((PROBE_MASK >> (BIT)) & 1u) { const unsigned long long _t1 = __builtin_amdgcn_s_memrealtime(); const unsigned long long _dt = _t1 - _t0_##BIT; while (__builtin_amdgcn_s_memrealtime() - _t1 < _dt) __builtin_amdgcn_s_sleep(8); }
constexpr int LDS_BYTES = 135168;
__global__ void __launch_bounds__(512, 2) fwd_megakernel(Params P) {
    extern __shared__ __attribute__((aligned(16))) unsigned char lds_raw[];
    LAS unsigned char* lds = (LAS unsigned char*)lds_raw;
    cg::grid_group grid = cg::this_grid();
    const int G = gridDim.x, bx = blockIdx.x;
    const int wave_s = __builtin_amdgcn_readfirstlane((int)threadIdx.x >> 6);
    const int vcu = (G % 8 == 0) ? (bx % 8) * (G / 8) + bx / 8 : bx;
    unsigned char* ws = P.ws;
    bf16_t* XN = (bf16_t*)(ws + WS_XN);
    volatile LAS unsigned* bst = (volatile LAS unsigned*)(lds + 131072 + 64);
    if (threadIdx.x < 2) bst[threadIdx.x] = 0u;
    __syncthreads();
    XcdBarrier bar; bar.bar = (unsigned*)ws + 1024; bar.x = xb_xcc_id(); bar.st = bst;
    if (threadIdx.x == 0) (void)xb_add(&bar.bar[XB_XCNT(bar.x)], 1u);
#define GRID_BAR() xcd_barrier(bar, wave_s)
    if (P.ws == nullptr) grid.sync();
    float* Y = P.out;

    for (int l = 0; l < DEPTH; ++l) {
        PH_BEGIN(0)
#ifndef X_NOPRE
        pre_phase(P, l, lds, vcu, G, l == 0 ? P.in[0] : Y, l == 0 ? P.in[1] : Y + (size_t)MP * DM, wave_s);
#endif
        PH_END(0)
        GRID_BAR();
        {
            PH_BEGIN(1)
            pg8::Gemm g{XN, (const bf16_t*)(ws + WS_WIN), MT, NIN, DM}; pg8::StaticOrder S; S.init(18, 26, 1, 16, G, bx);
            EpiG1a E{ws, P.out, P.in[10] + l * 64, P.in[11] + l * 64, P.in[12] + l * 64, P.in[13] + l * 64, P.in[9] + (size_t)l * 2 * DM, l};
#ifndef X_NOG1A
            pg8::gemm_phase<EpiG1a>(lds, g, S, E, wave_s);
#endif
            { const int rem = (64 * 18 + 26) % G, first = rem, nidle = rem ? G - rem : G;
              if (bx >= first) weight_items(P, l, 1, lds, (bx - first) * 8 + wave_s, nidle * 8, wave_s); }
            PH_END(1)
        }
        GRID_BAR();
        PH_BEGIN(2)
#ifndef X_NOATT
        attn_phase(P, l, lds, vcu, G, wave_s);
#endif
        PH_END(2)
        GRID_BAR();
        {
            PH_BEGIN(3)
            pg8::Gemm g{XN, (const bf16_t*)(ws + WS_WIN) + (size_t)NQKV * DM, MT, NIN - NQKV, DM}; pg8::StaticOrder S; S.init(8, 0, 1, 16, G, bx);
            EpiG1b E{(bf16_t*)(ws + WS_QA), (const bf16_t*)(ws + WS_QB), P.in[9] + (size_t)l * 2 * DM};
            {
                const int tidm = phase_tid(wave_s);
                for (int r = vcu; r < MS; r += G) {
                    bf16_t* oa = (bf16_t*)(ws + WS_QA) + (size_t)(MP + r) * DM + 2 * tidm; const bf16_t* ob = (const bf16_t*)(ws + WS_QB) + (size_t)(MP + r) * DM + 2 * tidm;
                    const bf16_t* gs = (const bf16_t*)(ws + WS_GS) + (size_t)r * 2048 + 2 * tidm;
                    const unsigned wa = *(const unsigned*)oa, wb = *(const unsigned*)ob, ga = *(const unsigned*)gs, gb = *(const unsigned*)(gs + DM);
                    const float m0 = bf2f((unsigned short)ga) * bf2f((unsigned short)wa) + bf2f((unsigned short)gb) * bf2f((unsigned short)wb);
                    const float m1 = bf2f((unsigned short)(ga >> 16)) * bf2f((unsigned short)(wa >> 16)) + bf2f((unsigned short)(gb >> 16)) * bf2f((unsigned short)(wb >> 16));
                    *(unsigned*)oa = cvt_pk_bf16(m0, m1);
                }
            }
#ifndef X_NOG1B
            pg8::gemm_phase<EpiG1b>(lds, g, S, E, wave_s);
#endif
            PH_END(3)
        }
        GRID_BAR();
        {
            PH_BEGIN(4)
            pg8::Gemm g{(const bf16_t*)(ws + WS_QA), (const bf16_t*)(ws + WS_WOUT), MT, DM, DM}; pg8::StaticOrder S; S.init(4, 4, 8, 16, G, bx);
            EpiRes E{l == 0 ? P.in[0] : Y, Y, (float*)(ws + WS_PART)};
            pg8::gemm_phase<EpiRes>(lds, g, S, E, wave_s);
            PH_END(4)
        }
        GRID_BAR();
        { PH_BEGIN(5)
        norm2_phase(P, l, vcu, G, wave_s);
        PH_END(5) }
        GRID_BAR();
        {
            PH_BEGIN(6)
            pg8::Gemm g{XN, (const bf16_t*)(ws + WS_WUP), MT, NUP, DM}; pg8::StaticOrder S; S.init(22, 22, 1, 16, G, bx);
            EpiG3 E{ws, P.out + O_PFC + (size_t)l * NBATCH * 2 * NUP, P.in[19] + (size_t)l * 3 * NUP, P.in[20] + (size_t)l * NUP};
#ifndef X_NOG3
            pg8::gemm_phase<EpiG3>(lds, g, S, E, wave_s);
#endif
            if (l + 1 < DEPTH) { const int rem = (64 * 22 + 22) % G, first = rem, nidle = rem ? G - rem : G;
              if (bx >= first) weight_items(P, l + 1, 0, lds, (bx - first) * 8 + wave_s, nidle * 8, wave_s, 0, 550); }
            PH_END(6)
        }
        GRID_BAR();
        { PH_BEGIN(7)
#ifndef X_NOFIX
        fix_phase(P, l, vcu, G, wave_s);
#endif
        PH_END(7) }
        GRID_BAR();
        {
            PH_BEGIN(8)
            pg8::Gemm g{(const bf16_t*)(ws + WS_ACT), (const bf16_t*)(ws + WS_WDN), MT, DM, DFF}; pg8::StaticOrder S; S.init(4, 4, 11, 44, G, bx);
                        EpiRes E{Y, Y, (float*)(ws + WS_PART)};
            pg8::gemm_phase<EpiRes>(lds, g, S, E, wave_s);
            PH_END(8)
        }
        GRID_BAR();
    }
    {
        const int tidt = phase_tid(wave_s), gtid = vcu * 512 + tidt;
        f32x4* ys = (f32x4*)(Y + (size_t)MP * DM); const f32x4* pp = (const f32x4*)(ws + WS_PART);
        for (int i = gtid; i < MS * DM / 4; i += G * 512) { f32x4 v = ys[i];
#pragma unroll
            for (int p = 0; p < 11; ++p) v += pp[(size_t)p * (MS * DM / 4) + i];
            ys[i] = v; }
    }
}

extern "C" void kernel_launch(void* const* d_in, const int* in_sizes, int n_in, void* d_out, int out_size, void* d_ws, size_t ws_size, hipStream_t stream) {
    static int grid_blocks = 0;
    if (grid_blocks == 0) {
        if (n_in != 22 || (size_t)out_size != O_END || ws_size < WS_END) { fprintf(stderr, "kernel_launch: unexpected shapes: n_in %d out %d ws %zu\n", n_in, out_size, ws_size); grid_blocks = -1; return; }
        int dev = 0, cus = 0, per_cu = 0;
        hipGetDevice(&dev); hipDeviceGetAttribute(&cus, hipDeviceAttributeMultiprocessorCount, dev);
        hipFuncSetAttribute((const void*)fwd_megakernel, hipFuncAttributeMaxDynamicSharedMemorySize, LDS_BYTES);
        hipOccupancyMaxActiveBlocksPerMultiprocessor(&per_cu, (const void*)fwd_megakernel, 512, LDS_BYTES);
        if (per_cu < 1) { fprintf(stderr, "kernel_launch: occupancy query says %d blocks/CU\n", per_cu); per_cu = 1; }
        (void)hipGetLastError();
        grid_blocks = cus;
    }
    if (grid_blocks < 0) return;
    (void)hipMemsetAsync(d_ws, 0, 65536, stream);
    Params p{};
    for (int i = 0; i < 22; ++i) p.in[i] = (const float*)d_in[i];
    p.out = (float*)d_out; p.ws = (unsigned char*)d_ws;
    void* args[] = {&p};
    hipError_t e = hipLaunchCooperativeKernel((const void*)fwd_megakernel, dim3(grid_blocks), dim3(512), args, LDS_BYTES, stream);
    if (e != hipSuccess) fprintf(stderr, "cooperative launch failed: %s (grid %d)\n", hipGetErrorString(e), grid_blocks);
}
```

```cpp
#include <hip/hip_runtime.h>
#include <hip/hip_cooperative_groups.h>
#include <cstdio>
#include <cstdint>
namespace cg = cooperative_groups;

#define LAS __attribute__((address_space(3)))
typedef unsigned short bf16_t;
typedef short bf16x8 __attribute__((ext_vector_type(8)));
typedef float f32x4 __attribute__((ext_vector_type(4)));
typedef float f32x2 __attribute__((ext_vector_type(2)));
typedef float f32x16 __attribute__((ext_vector_type(16)));
typedef unsigned u32x4 __attribute__((ext_vector_type(4)));
typedef unsigned u32x2 __attribute__((ext_vector_type(2)));
typedef __bf16 bf16x2_t __attribute__((ext_vector_type(2)));

constexpr int DM = 1024, MP = 16384, MS = 256, MT = MP + MS, SEQ = 4096, NBATCH = 4, SBATCH = 8, STOK = 32;
constexpr int NIN = 6656, NQKV = 4608, DFF = 2816, NUP = 5632, DEPTH = 2;
constexpr int NT32 = SEQ / 32;
constexpr int NBS_A = 5, NBS_B = 17;
constexpr float EPS = 1e-6f, LOG2E = 1.4426950408889634f;

constexpr size_t O_YP = 0, O_YS = 16777216, O_PAK = 17039360, O_PAV = 17301504, O_PBK = 17563648, O_PBV = 21757952,
                 O_PFC = 25952256, O_SAK = 26042368, O_SAV = 26173440, O_SBK = 26304512, O_SBV = 26828800, O_SFC = 27353088,
                 O_END = 27533312;
constexpr size_t MiB = 1u << 20;
constexpr size_t WS_WIN = 1 * MiB, WS_WOUT = 14 * MiB, WS_WUP = 16 * MiB, WS_WDN = 27 * MiB, WS_XN = 33 * MiB, WS_QA = 66 * MiB, WS_QB = 99 * MiB,
                 WS_KA = 132 * MiB, WS_VA = 140 * MiB, WS_KB = 148 * MiB, WS_VB = 180 * MiB, WS_KAS = 212 * MiB, WS_VAS = 213 * MiB,
                 WS_KBS = 214 * MiB, WS_VBS = 223 * MiB, WS_ACT = 66 * MiB, WS_HU = 156 * MiB, WS_US = 178 * MiB, WS_GS = 232 * MiB, WS_PART = 233 * MiB, WS_END = 245 * MiB;

struct Params { const float* in[22]; float* out; unsigned char* ws; };

__device__ __forceinline__ unsigned cvt_pk_bf16(float lo, float hi) { f32x2 v = {lo, hi}; bf16x2_t b = __builtin_convertvector(v, bf16x2_t); return __builtin_bit_cast(unsigned, b); }
__device__ __forceinline__ float bf2f(unsigned short b) { return __builtin_bit_cast(float, (unsigned)b << 16); }

__device__ __forceinline__ int phase_tid(int wave_s) { int lane; asm volatile("v_mbcnt_lo_u32_b32 %0, -1, 0\n\tv_mbcnt_hi_u32_b32 %0, -1, %0" : "=v"(lane)); return wave_s * 64 + lane; }
namespace pg8 {
constexpr int BM = 256, BK = 64, HALF = 128, HTB = HALF * BK * 2, STAGE_BYTES = 8 * HTB, NXCD = 8, WGM = 2;
__host__ __device__ __forceinline__ int lds_byte(int r, int c) { const int st = (r >> 4) * 2 + (c >> 5), rr = r & 15, cc = c & 31, ob = rr * 64 + cc * 2; return st * 1024 + (ob ^ (((ob >> 9) & 1) << 5)); }
__host__ __device__ __forceinline__ void stage_rc(int b, int& R, int& C) { const int st = b / 1024, sb = b % 1024, swz = sb ^ (((sb >> 9) & 1) << 5); R = (st >> 1) * 16 + swz / 64; C = (st & 1) * 32 + (swz % 64) / 2; }
__host__ __device__ __forceinline__ int perm32(int rho) { const int n = rho >> 4, i = rho & 15; return 8 * (i >> 2) + 4 * n + (i & 3); }

struct Unit { int pm, pn, k0, nt; };
struct Gemm { const bf16_t* A; const bf16_t* Bt; int M, N, K; };

struct StaticOrder {
    int nNp, nP, nNs, nS, ntp, nts, G, c;
    __device__ void init(int nNp_, int nNs_, int nsplit, int ntfull, int G_, int c_) { nNp = nNp_; nP = 64 * nNp_; nNs = nNs_; nS = nNs_ * nsplit; ntp = ntfull; nts = ntfull / nsplit; G = G_; c = c_; }
    __device__ bool next(int i, Unit& u) const {
        const int L = i * G + c; if (L >= nP + nS) return false;
        if (L >= nP) { const int sI = L - nP; u.pm = 64; u.pn = sI % nNs; u.k0 = (sI / nNs) * nts; u.nt = nts; return true; }
        int wgid = L; { const int q = nP / NXCD, xcd = wgid % NXCD, off = wgid / NXCD; wgid = xcd * q + off; }
        const int nig = WGM * nNp, gid = wgid / nig, fm = gid * WGM;
        u.pm = fm + ((wgid % nig) % WGM); u.pn = (wgid % nig) / WGM; u.k0 = 0; u.nt = ntp; return true;
    }
};

template <class Epi>
__device__ __forceinline__ void gemm_phase(LAS unsigned char* lds, Gemm g, const StaticOrder& S, const Epi& E, int wave_s) {
    int tid_ = phase_tid(wave_s);
    asm volatile("" : "+s"(g.A), "+s"(g.Bt));
    const int tid = tid_, wid = __builtin_amdgcn_readfirstlane(tid >> 6), lane = tid & 63, wr = wid >> 2, wc = wid & 3, fr = lane & 15, fq = lane >> 4;
    const int K = g.K;
    unsigned voffA[2], voffB[2];
#pragma unroll
    for (int i = 0; i < 2; ++i) { int R, C; stage_rc(tid * 16 + i * 8192, R, C); const int Rb = (R & ~31) + perm32(R & 31);
        const int Ra = Epi::APERM ? ((R & ~63) + 4 * (R & 15) + ((R >> 4) & 3)) : R;
        voffA[i] = (unsigned)(Ra * K + C) * 2u; voffB[i] = (unsigned)(Rb * K + C) * 2u; }
    const size_t kstep = (size_t)(BK * 2);
    const size_t hstep = (size_t)HALF * K * 2;
    const size_t tstep = 2 * hstep;
    const unsigned ldsw = (unsigned)wid * 1024u;
    const int aoff = lds_byte(wr * 64 + fr, fq * 8), boff = lds_byte(wc * 32 + fr, fq * 8);
#define PG8_SA(b, h) (((b) * 2 + (h)) * HTB)
#define PG8_SB(b, h) ((4 + (b) * 2 + (h)) * HTB)
#define PG8_STAGE(bufoff, gbase, voff) do { _Pragma("unroll") for (int _i = 0; _i < 2; ++_i) \
        __builtin_amdgcn_global_load_lds((const unsigned*)((const char*)(gbase) + (voff)[_i]), (LAS unsigned*)(lds + (bufoff) + ldsw + _i * 8192), 16, 0, 0); } while (0)
#define PG8_LDA(dst, b, h) do { _Pragma("unroll") for (int m = 0; m < 4; ++m) _Pragma("unroll") for (int k = 0; k < 2; ++k) dst[m][k] = *(const LAS bf16x8*)(lds + PG8_SA(b, h) + aoff + m * 2048 + k * 1024); } while (0)
#define PG8_LDB(dst, b, h) do { _Pragma("unroll") for (int n = 0; n < 2; ++n) _Pragma("unroll") for (int k = 0; k < 2; ++k) dst[n][k] = *(const LAS bf16x8*)(lds + PG8_SB(b, h) + boff + n * 2048 + k * 1024); } while (0)
#define PG8_MMA(ai, bj, At, Bt) do { __builtin_amdgcn_s_setprio(1); _Pragma("unroll") for (int m = 0; m < 4; ++m) _Pragma("unroll") for (int n = 0; n < 2; ++n) _Pragma("unroll") for (int k = 0; k < 2; ++k) \
        acc[ai][bj][m][n] = __builtin_amdgcn_mfma_f32_16x16x32_bf16(Bt[n][k], At[m][k], acc[ai][bj][m][n], 0, 0, 0); __builtin_amdgcn_s_setprio(0); } while (0)
#define PG8_WAIT_V(n) asm volatile("s_waitcnt vmcnt(" #n ")" ::: "memory")
#define PG8_WAIT_L(n) asm volatile("s_waitcnt lgkmcnt(" #n ")" ::: "memory")
#define PG8_BAR __builtin_amdgcn_s_barrier()
#define PG8_SCHED __builtin_amdgcn_sched_barrier(0)
    Unit cur, nxt; int ui = 0;
    if (!S.next(0, cur)) return;
    f32x4 acc[2][2][4][2];
#pragma unroll
    for (int a = 0; a < 2; ++a)
#pragma unroll
        for (int b = 0; b < 2; ++b)
#pragma unroll
            for (int m = 0; m < 4; ++m)
#pragma unroll
                for (int n = 0; n < 2; ++n) acc[a][b][m][n] = (f32x4){0.f, 0.f, 0.f, 0.f};
    bf16x8 At[4][2], B0[2][2], B1[2][2];
    const char* cA = (const char*)g.A + (size_t)cur.pm * tstep + (size_t)cur.k0 * kstep; const char* cB = (const char*)g.Bt + (size_t)cur.pn * tstep + (size_t)cur.k0 * kstep;
    PG8_STAGE(PG8_SB(0, 0), cB, voffB); PG8_STAGE(PG8_SB(0, 1), cB + hstep, voffB); PG8_STAGE(PG8_SA(0, 0), cA, voffA); PG8_STAGE(PG8_SA(0, 1), cA + hstep, voffA);
    if (wr == 1) PG8_BAR;
    PG8_WAIT_V(2); PG8_BAR;
    PG8_STAGE(PG8_SB(1, 0), cB + kstep, voffB); PG8_STAGE(PG8_SA(1, 0), cA + kstep, voffA); PG8_STAGE(PG8_SB(1, 1), cB + hstep + kstep, voffB);
    PG8_WAIT_V(6); PG8_BAR;
    for (;;) {
        const bool has_next = S.next(ui + 1, nxt);
        const char* nA = has_next ? (const char*)g.A + (size_t)nxt.pm * tstep + (size_t)nxt.k0 * kstep : cA; const char* nB = has_next ? (const char*)g.Bt + (size_t)nxt.pn * tstep + (size_t)nxt.k0 * kstep : cB;
        const int nt = cur.nt;
        for (int t = 0; t < nt; t += 2) {
            const bool last = (t == nt - 2);
            const char* a1 = cA + (size_t)(t + 1) * kstep;
            const char* a2 = last ? nA : cA + (size_t)(t + 2) * kstep; const char* b2 = last ? nB : cB + (size_t)(t + 2) * kstep;
            const char* a3 = a2 + kstep; const char* b3 = b2 + kstep;
            PG8_LDB(B0, 0, 0); PG8_LDB(B1, 0, 1); PG8_SCHED; PG8_LDA(At, 0, 0); PG8_STAGE(PG8_SA(1, 1), a1 + hstep, voffA);
            PG8_WAIT_V(8); PG8_WAIT_L(0); PG8_BAR; PG8_MMA(0, 0, At, B0); PG8_MMA(0, 1, At, B1); PG8_BAR; PG8_SCHED;
            PG8_LDA(At, 0, 1); PG8_STAGE(PG8_SB(0, 0), b2, voffB); PG8_STAGE(PG8_SB(0, 1), b2 + hstep, voffB); PG8_STAGE(PG8_SA(0, 0), a2, voffA);
            PG8_WAIT_V(8); PG8_WAIT_L(0); PG8_BAR; PG8_MMA(1, 0, At, B0); PG8_MMA(1, 1, At, B1); PG8_BAR; PG8_SCHED;
            PG8_LDB(B0, 1, 0); PG8_LDB(B1, 1, 1); PG8_SCHED; PG8_LDA(At, 1, 0); PG8_STAGE(PG8_SA(0, 1), a2 + hstep, voffA);
            PG8_WAIT_V(8); PG8_WAIT_L(0); PG8_BAR; PG8_MMA(0, 0, At, B0); PG8_MMA(0, 1, At, B1); PG8_BAR; PG8_SCHED;
            PG8_LDA(At, 1, 1); PG8_STAGE(PG8_SB(1, 0), b3, voffB); PG8_STAGE(PG8_SB(1, 1), b3 + hstep, voffB); PG8_STAGE(PG8_SA(1, 0), a3, voffA);
            PG8_WAIT_V(8); PG8_WAIT_L(0); PG8_BAR; PG8_MMA(1, 0, At, B0); PG8_MMA(1, 1, At, B1); PG8_BAR; PG8_SCHED;
        }
        if (wr == 0) PG8_BAR;
        E(acc, cur, wr, wc, fr, fq);
        if (!has_next) break;
#pragma unroll
        for (int a = 0; a < 2; ++a)
#pragma unroll
            for (int b = 0; b < 2; ++b)
#pragma unroll
                for (int m = 0; m < 4; ++m)
#pragma unroll
                    for (int n = 0; n < 2; ++n) acc[a][b][m][n] = (f32x4){0.f, 0.f, 0.f, 0.f};
        cur = nxt; cA = nA; cB = nB; ++ui;
        if (wr == 1) PG8_BAR;
    }
    PG8_WAIT_V(0);
    PG8_BAR;
#undef PG8_SA
#undef PG8_SB
#undef PG8_STAGE
#undef PG8_LDA
#undef PG8_LDB
#undef PG8_MMA
#undef PG8_WAIT_V
#undef PG8_WAIT_L
#undef PG8_BAR
#undef PG8_SCHED
}
}
using pg8::Unit;
typedef const f32x4 (&AccRef)[2][2][4][2];

__device__ __forceinline__ float gelu1(float v) {
    const float av = __builtin_fabsf(v), d = av * 0.2316418882f + 1.0f;
    const float t = __builtin_amdgcn_rcpf(d);
    float q = t * 0.5307027145f + (-0.7265760135f); q = q * t + 0.7107068705f; q = q * t + (-0.142248368f); q = q * t + 0.127414796f; q = q * t;
    const float e = __builtin_amdgcn_exp2f((v * v) * (-0.72134752044f));
    const float m = v * (q * e), r = v - m;
    return v < 0.f ? m : r;
}
__device__ __forceinline__ float sigmoidf_(float x) { return __builtin_amdgcn_rcpf(1.0f + __builtin_amdgcn_exp2f(-x * LOG2E)); }

struct EpiG1a {
    static constexpr bool APERM = false;
    unsigned char* ws; float* out; const float *gqa, *gka, *gqb, *gkb; const float* bg; int l;
    __device__ __forceinline__ void operator()(AccRef acc, const Unit& u, int wr, int wc, int fr, int fq) const {
        asm volatile("" : "+v"(fr), "+v"(fq));
        const int pn = u.pn; const bool samp = (u.pm == 64);
        if (pn >= 18) {
            bf16_t* GS = (bf16_t*)(ws + WS_GS); const int c0 = (pn - 18) * 128 + wc * 32 + 8 * fq;
#pragma unroll
            for (int bj = 0; bj < 2; ++bj) {
                const f32x4 b0 = *(const f32x4*)(bg + bj * DM + c0), b1 = *(const f32x4*)(bg + bj * DM + c0 + 4);
#pragma unroll
                for (int ai = 0; ai < 2; ++ai)
#pragma unroll
                    for (int m = 0; m < 4; ++m) {
                        const f32x4 a = acc[ai][bj][m][0] + b0, c = acc[ai][bj][m][1] + b1;
                        u32x4 w; w.x = cvt_pk_bf16(sigmoidf_(a[0]), sigmoidf_(a[1])); w.y = cvt_pk_bf16(sigmoidf_(a[2]), sigmoidf_(a[3])); w.z = cvt_pk_bf16(sigmoidf_(c[0]), sigmoidf_(c[1])); w.w = cvt_pk_bf16(sigmoidf_(c[2]), sigmoidf_(c[3]));
                        *(u32x4*)(GS + (size_t)(ai * 128 + wr * 64 + m * 16 + fr) * 2048 + bj * DM + c0) = w;
                    }
            }
            return;
        }
        int ty, hs, mb;
        if (pn < 4) { ty = 0; mb = 0; hs = pn * 4 + wc; } else if (pn == 4) { ty = 1; mb = 0; hs = wc; } else if (pn == 5) { ty = 2; mb = 0; hs = wc; }
        else if (pn < 10) { ty = 0; mb = 1; hs = (pn - 6) * 4 + wc; } else if (pn < 14) { ty = 1; mb = 1; hs = (pn - 10) * 4 + wc; } else { ty = 2; mb = 1; hs = (pn - 14) * 4 + wc; }
        if (ty == 0) {
            bf16_t* Q = (bf16_t*)(ws + (mb ? WS_QB : WS_QA)); const float* gg = mb ? gqb : gqa;
            f32x4 gv[2][2];
#pragma unroll
            for (int bj = 0; bj < 2; ++bj)
#pragma unroll
                for (int n = 0; n < 2; ++n) gv[bj][n] = *(const f32x4*)(gg + 32 * bj + 8 * fq + 4 * n);
#pragma unroll
            for (int ai = 0; ai < 2; ++ai)
#pragma unroll
                for (int m = 0; m < 4; ++m) {
                    float ss = 0.f;
#pragma unroll
                    for (int bj = 0; bj < 2; ++bj)
#pragma unroll
                        for (int n = 0; n < 2; ++n) { const f32x4 x = acc[ai][bj][m][n]; ss += (x[0] * x[0] + x[1] * x[1]) + (x[2] * x[2] + x[3] * x[3]); }
                    ss += __shfl_xor(ss, 16); ss += __shfl_xor(ss, 32);
                    const float rs = __builtin_amdgcn_rsqf(ss * (1.0f / 64.0f) + EPS);
                    const size_t row = (size_t)u.pm * 256 + ai * 128 + wr * 64 + m * 16 + fr;
                    bf16_t* qp = Q + row * DM + hs * 64 + 8 * fq;
#pragma unroll
                    for (int bj = 0; bj < 2; ++bj) {
                        const f32x4 a = acc[ai][bj][m][0] * rs * gv[bj][0], b = acc[ai][bj][m][1] * rs * gv[bj][1];
                        u32x4 w; w.x = cvt_pk_bf16(a[0], a[1]); w.y = cvt_pk_bf16(a[2], a[3]); w.z = cvt_pk_bf16(b[0], b[1]); w.w = cvt_pk_bf16(b[2], b[3]);
                        *(u32x4*)(qp + 32 * bj) = w;
                    }
                }
            return;
        }
        const int H = mb ? 16 : 4, W = mb ? 512 : 128, NBS = mb ? NBS_B : NBS_A;
        bf16_t* KVp = (bf16_t*)(ws + ((ty == 1) ? (mb ? WS_KB : WS_KA) : (mb ? WS_VB : WS_VA)));
        bf16_t* KVs = (bf16_t*)(ws + ((ty == 1) ? (mb ? WS_KBS : WS_KAS) : (mb ? WS_VBS : WS_VAS)));
        float* op = out + ((ty == 1) ? (mb ? O_PBK : O_PAK) : (mb ? O_PBV : O_PAV)) + (size_t)l * NBATCH * W * H * 64;
        float* os = out + ((ty == 1) ? (mb ? O_SBK : O_SAK) : (mb ? O_SBV : O_SAV)) + (size_t)l * SBATCH * STOK * H * 64;
        f32x4 gv[2][2];
#pragma unroll
        for (int bj = 0; bj < 2; ++bj)
#pragma unroll
            for (int n = 0; n < 2; ++n) gv[bj][n] = (ty == 1) ? *(const f32x4*)((mb ? gkb : gka) + 32 * bj + 8 * fq + 4 * n) : (f32x4){1.f, 1.f, 1.f, 1.f};
#pragma unroll
        for (int ai = 0; ai < 2; ++ai)
#pragma unroll
            for (int m = 0; m < 4; ++m) {
                float rs = 1.0f;
                if (ty == 1) {
                    float ss = 0.f;
#pragma unroll
                    for (int bj = 0; bj < 2; ++bj)
#pragma unroll
                        for (int n = 0; n < 2; ++n) { const f32x4 x = acc[ai][bj][m][n]; ss += (x[0] * x[0] + x[1] * x[1]) + (x[2] * x[2] + x[3] * x[3]); }
                    ss += __shfl_xor(ss, 16); ss += __shfl_xor(ss, 32);
                    rs = __builtin_amdgcn_rsqf(ss * (1.0f / 64.0f) + EPS);
                }
                const int rloc = ai * 128 + wr * 64 + m * 16 + fr;
                int b, t, kidx; bf16_t* blk; float* fo = nullptr;
                if (!samp) { b = u.pm >> 4; t = (u.pm & 15) * 256 + rloc; kidx = t; blk = KVp + ((size_t)(b * H + hs) * NT32 + (t >> 5)) * 2048;
                    if (t >= SEQ - W) fo = op + ((size_t)(b * W + (t - (SEQ - W))) * H + hs) * 64; }
                else { b = rloc >> 5; t = rloc & 31; kidx = W + t; blk = KVs + ((size_t)(b * H + hs) * NBS + (kidx >> 5)) * 2048;
                    fo = os + ((size_t)(b * STOK + t) * H + hs) * 64; }
                const int tt = kidx & 31;
#pragma unroll
                for (int bj = 0; bj < 2; ++bj) {
                    const f32x4 a = acc[ai][bj][m][0] * rs * gv[bj][0], c = acc[ai][bj][m][1] * rs * gv[bj][1];
                    if (fo) { *(f32x4*)(fo + 32 * bj + 8 * fq) = a; *(f32x4*)(fo + 32 * bj + 8 * fq + 4) = c; }
                    if (ty == 1) {
                        u32x4 w; w.x = cvt_pk_bf16(a[0], a[1]); w.y = cvt_pk_bf16(a[2], a[3]); w.z = cvt_pk_bf16(c[0], c[1]); w.w = cvt_pk_bf16(c[2], c[3]);
                        *(u32x4*)(blk + ((fq * 2 + bj) * 32 + tt) * 8) = w;
                    } else {
                        const int s = tt >> 4, u16 = tt & 15, hi = (u16 >> 2) & 1, j = (u16 & 3) + 4 * (u16 >> 3);
                        bf16_t* vp = blk + (((s * 2 + bj) * 2 + hi) * 32 + 8 * fq) * 8 + j;
                        const unsigned p0 = cvt_pk_bf16(a[0], a[1]), p1 = cvt_pk_bf16(a[2], a[3]), p2 = cvt_pk_bf16(c[0], c[1]), p3 = cvt_pk_bf16(c[2], c[3]);
                        vp[0] = (bf16_t)p0; vp[8] = (bf16_t)(p0 >> 16); vp[16] = (bf16_t)p1; vp[24] = (bf16_t)(p1 >> 16);
                        vp[32] = (bf16_t)p2; vp[40] = (bf16_t)(p2 >> 16); vp[48] = (bf16_t)p3; vp[56] = (bf16_t)(p3 >> 16);
                    }
                }
                asm volatile("" ::: "memory");
            }
    }
};
struct EpiG1b {
    static constexpr bool APERM = false;
    bf16_t *OA; const bf16_t* OB; const float* bg;
    __device__ __forceinline__ void operator()(AccRef acc, const Unit& u, int wr, int wc, int fr, int fq) const {
        asm volatile("" : "+v"(fr), "+v"(fq));
        const int c0 = u.pn * 128 + wc * 32 + 8 * fq;
        f32x4 ba[2], bb[2];
#pragma unroll
        for (int n = 0; n < 2; ++n) { ba[n] = *(const f32x4*)(bg + c0 + 4 * n); bb[n] = *(const f32x4*)(bg + DM + c0 + 4 * n); }
#pragma unroll
        for (int ai = 0; ai < 2; ++ai)
#pragma unroll
            for (int m = 0; m < 4; ++m) {
                const size_t off = ((size_t)u.pm * 256 + ai * 128 + wr * 64 + m * 16 + fr) * DM + c0;
                const u32x4 oa = *(const u32x4*)(OA + off), ob = *(const u32x4*)(OB + off);
                float r[8];
#pragma unroll
                for (int n = 0; n < 2; ++n)
#pragma unroll
                    for (int e = 0; e < 4; ++e) {
                        const int j = 4 * n + e; const unsigned wa = oa[j >> 1], wb = ob[j >> 1];
                        const float fa = (j & 1) ? __builtin_bit_cast(float, wa & 0xffff0000u) : __builtin_bit_cast(float, wa << 16);
                        const float fb = (j & 1) ? __builtin_bit_cast(float, wb & 0xffff0000u) : __builtin_bit_cast(float, wb << 16);
                                r[j] = sigmoidf_(acc[ai][0][m][n][e] + ba[n][e]) * fa + sigmoidf_(acc[ai][1][m][n][e] + bb[n][e]) * fb;
                    }
                u32x4 w; w.x = cvt_pk_bf16(r[0], r[1]); w.y = cvt_pk_bf16(r[2], r[3]); w.z = cvt_pk_bf16(r[4], r[5]); w.w = cvt_pk_bf16(r[6], r[7]);
                *(u32x4*)(OA + off) = w;
                asm volatile("" ::: "memory");
            }
    }
};
struct EpiRes {
    static constexpr bool APERM = false;
    const float* xin_p; float* xout; float* part;
    __device__ __forceinline__ void operator()(AccRef acc, const Unit& u, int wr, int wc, int fr, int fq) const {
        asm volatile("" : "+v"(fr), "+v"(fq));
        float* ob = xout + (size_t)u.pm * 256 * DM;
        if (u.pm == 64) {
            float* pb = part + (size_t)(u.k0 / u.nt) * MS * DM;
#pragma unroll
            for (int ai = 0; ai < 2; ++ai)
#pragma unroll
                for (int m = 0; m < 4; ++m) {
                    const size_t off = (size_t)(ai * 128 + wr * 64 + m * 16 + fr) * DM + u.pn * 256 + wc * 32 + 8 * fq;
#pragma unroll
                    for (int bj = 0; bj < 2; ++bj)
#pragma unroll
                        for (int n = 0; n < 2; ++n) *(f32x4*)(pb + off + bj * 128 + 4 * n) = acc[ai][bj][m][n];
                }
            return;
        }
        const float* xb = xin_p + (size_t)u.pm * 256 * DM;
#pragma unroll
        for (int ai = 0; ai < 2; ++ai)
#pragma unroll
            for (int m = 0; m < 4; ++m) {
                const size_t off = (size_t)(ai * 128 + wr * 64 + m * 16 + fr) * DM + u.pn * 256 + wc * 32 + 8 * fq;
#pragma unroll
                for (int bj = 0; bj < 2; ++bj)
#pragma unroll
                    for (int n = 0; n < 2; ++n) { const f32x4 x = *(const f32x4*)(xb + off + bj * 128 + 4 * n); *(f32x4*)(ob + off + bj * 128 + 4 * n) = x + acc[ai][bj][m][n]; }
                asm volatile("" ::: "memory");
            }
    }
};
__device__ __forceinline__ float dpp_shr1(float x) { return __builtin_bit_cast(float, __builtin_amdgcn_update_dpp(0, __builtin_bit_cast(int, x), 0x111  , 0xf, 0xf, false)); }
__device__ __forceinline__ f32x4 dpp_prev_lane(f32x4 v) {
    const float a = dpp_shr1(v.x), b = dpp_shr1(v.y), c = dpp_shr1(v.z), d = dpp_shr1(v.w);
    return (f32x4){a, b, c, d};
}
struct EpiG3 {
    static constexpr bool APERM = true;
    unsigned char* ws; float* o_pfc; const float* cw; const float* cb;
    __device__ __forceinline__ void operator()(AccRef acc, const Unit& u, int wr, int wc, int fr, int fq) const {
        asm volatile("" : "+v"(fr), "+v"(fq));
        bf16_t* ACT = (bf16_t*)(ws + WS_ACT); float* HU = (float*)(ws + WS_HU); float* US = (float*)(ws + WS_US);
        const int ca0 = u.pn * 128 + wc * 32 + 8 * fq;
        if (u.pm == 64) {
#pragma unroll
            for (int ai = 0; ai < 2; ++ai)
#pragma unroll
                for (int m = 0; m < 4; ++m) { float* p = US + (size_t)(ai * 128 + wr * 64 + 4 * fr + m) * NUP + ca0;
#pragma unroll
                    for (int bj = 0; bj < 2; ++bj)
#pragma unroll
                        for (int n = 0; n < 2; ++n) *(f32x4*)(p + bj * DFF + 4 * n) = acc[ai][bj][m][n]; }
            return;
        }
#pragma unroll
        for (int ai = 0; ai < 2; ++ai) {
            const int seg = u.pm * 4 + ai * 2 + wr;
            const size_t row0 = (size_t)u.pm * 256 + ai * 128 + wr * 64 + 4 * fr;
            const bool lastseg = ((u.pm & 15) == 15) && ai == 1 && wr == 1;
#pragma unroll
            for (int n = 0; n < 2; ++n) {
                f32x4 cg[4];
#pragma unroll
                for (int bj = 1; bj >= 0; --bj) {
                    const int col = bj * DFF + ca0 + 4 * n;
                    const f32x4 w0 = *(const f32x4*)(cw + col), w1 = *(const f32x4*)(cw + NUP + col), w2 = *(const f32x4*)(cw + 2 * NUP + col), bb = *(const f32x4*)(cb + col);
                    const f32x4 x0 = acc[ai][bj][0][n], x1 = acc[ai][bj][1][n], x2 = acc[ai][bj][2][n], x3 = acc[ai][bj][3][n];
                    const f32x4 p1 = dpp_prev_lane(x3), p2 = dpp_prev_lane(x2);
                    if (fr == 0) { float* h = HU + (size_t)seg * 4 * NUP + col; *(f32x4*)h = x0; *(f32x4*)(h + NUP) = x1; }
                    if (fr == 15) { float* h = HU + (size_t)seg * 4 * NUP + 2 * NUP + col; *(f32x4*)h = x2; *(f32x4*)(h + NUP) = x3;
                        if (lastseg) { float* o = o_pfc + (size_t)(u.pm >> 4) * 2 * NUP + col; *(f32x4*)o = x2; *(f32x4*)(o + NUP) = x3; } }
                    f32x4 c[4];
                    c[0] = bb + w0 * p2 + w1 * p1 + w2 * x0;
                    c[1] = bb + w0 * p1 + w1 * x0 + w2 * x1;
                    c[2] = bb + w0 * x0 + w1 * x1 + w2 * x2;
                    c[3] = bb + w0 * x1 + w1 * x2 + w2 * x3;
                    if (bj == 1) {
#pragma unroll
                        for (int m = 0; m < 4; ++m) cg[m] = c[m];
                    } else {
#pragma unroll
                        for (int m = 0; m < 4; ++m) {
                            const float a0 = gelu1(c[m][0]) * cg[m][0], a1 = gelu1(c[m][1]) * cg[m][1], a2 = gelu1(c[m][2]) * cg[m][2], a3 = gelu1(c[m][3]) * cg[m][3];
                            u32x2 w; w.x = cvt_pk_bf16(a0, a1); w.y = cvt_pk_bf16(a2, a3);
                            *(u32x2*)(ACT + (row0 + m) * DFF + ca0 + 4 * n) = w;
                        }
                    }
                }
                asm volatile("" ::: "memory");
            }
        }
    }
};

__device__ __forceinline__ float wave_sum(float v) {
#pragma unroll
    for (int o = 1; o < 64; o <<= 1) v += __shfl_xor(v, o);
    return v;
}
__device__ __forceinline__ void transpose_item(const float* W, int K, int Nsrc, bf16_t* WT, int kb, int nb, int sb, LAS float* scr, int lane) {
    const int k0 = 64 * kb, n0 = 32 * nb, s0 = 32 * sb;
#pragma unroll 8
    for (int i = 0; i < 32; ++i) { const int kk = 2 * i + (lane >> 5); scr[kk * 33 + (lane & 31)] = W[(size_t)(k0 + kk) * Nsrc + s0 + (lane & 31)]; }
    asm volatile("s_waitcnt lgkmcnt(0)" ::: "memory");
    const int c = lane & 7;
#pragma unroll
    for (int j = 0; j < 4; ++j) { const int n = (lane >> 3) + 8 * j; const LAS float* s = scr + (8 * c) * 33 + n;
        u32x4 o; o.x = cvt_pk_bf16(s[0 * 33], s[1 * 33]); o.y = cvt_pk_bf16(s[2 * 33], s[3 * 33]); o.z = cvt_pk_bf16(s[4 * 33], s[5 * 33]); o.w = cvt_pk_bf16(s[6 * 33], s[7 * 33]);
        *(u32x4*)(WT + (size_t)(n0 + n) * K + k0 + 8 * c) = o; }
    asm volatile("s_waitcnt lgkmcnt(0)" ::: "memory");
}
__device__ __forceinline__ int win_srcblk(int nb) {
    const int pn = nb >> 3, sb = nb & 7, bj = sb >> 2, wc = sb & 3;
    if (pn < 18) return 8 * pn + 2 * wc + bj;
    return 144 + 32 * bj + 4 * (pn - 18) + wc;
}
__device__ __forceinline__ int wup_srcblk(int nb) { const int pn = nb >> 3, sb = nb & 7, bj = sb >> 2; return 88 * bj + 4 * pn + (sb & 3); }

__device__ __forceinline__ void norm_row(const float* xrow, const float* g, bf16_t* orow, int lane, const float* part = nullptr, int nparts = 0, float* xw = nullptr) {
    const f32x4* xr = (const f32x4*)xrow + lane; const f32x4* gr = (const f32x4*)g + lane;
    f32x4 v[4]; float s = 0.f;
#pragma unroll
    for (int j = 0; j < 4; ++j) v[j] = xr[64 * j];
    if (nparts > 0) {
        typedef const __attribute__((address_space(1))) f32x4* gv4;
        int p = 0;
        for (; p + 4 <= nparts; p += 4) { f32x4 t[4][4];
#pragma unroll
            for (int q = 0; q < 4; ++q)
#pragma unroll
                for (int j = 0; j < 4; ++j) t[q][j] = *((gv4)(part + (size_t)(p + q) * MS * DM) + lane + 64 * j);
#pragma unroll
            for (int j = 0; j < 4; ++j) v[j] += (t[0][j] + t[1][j]) + (t[2][j] + t[3][j]); }
        for (; p < nparts; ++p) { const f32x4* pr = (const f32x4*)(part + (size_t)p * MS * DM) + lane;
#pragma unroll
            for (int j = 0; j < 4; ++j) v[j] += pr[64 * j]; }
        f32x4* wr_ = (f32x4*)xw + lane;
#pragma unroll
        for (int j = 0; j < 4; ++j) wr_[64 * j] = v[j];
    }
#pragma unroll
    for (int j = 0; j < 4; ++j) s += (v[j].x * v[j].x + v[j].y * v[j].y) + (v[j].z * v[j].z + v[j].w * v[j].w);
    const float rstd = __builtin_amdgcn_rsqf(wave_sum(s) * (1.f / DM) + EPS);
    u32x2* o8 = (u32x2*)orow + lane;
#pragma unroll
    for (int j = 0; j < 4; ++j) { const f32x4 gg = gr[64 * j]; u32x2 w; w.x = cvt_pk_bf16(v[j].x * rstd * gg.x, v[j].y * rstd * gg.y); w.y = cvt_pk_bf16(v[j].z * rstd * gg.z, v[j].w * rstd * gg.w); o8[64 * j] = w; }
}
__device__ __forceinline__ void norm_rows(const float* x, const float* g, bf16_t* XN, int gw, int NGW, int lane) {
    typedef const __attribute__((address_space(1))) f32x4* gv4;
    const f32x4* gr = (const f32x4*)g + lane;
    f32x4 gg[4];
#pragma unroll
    for (int j = 0; j < 4; ++j) gg[j] = gr[64 * j];
    int m = gw; if (m >= MP) return;
    f32x4 vn[4];
#pragma unroll
    for (int j = 0; j < 4; ++j) vn[j] = __builtin_nontemporal_load((gv4)(x + (size_t)m * DM) + lane + 64 * j);
    for (; m < MP; m += NGW) {
        f32x4 v[4];
#pragma unroll
        for (int j = 0; j < 4; ++j) v[j] = vn[j];
        const int mn = m + NGW;
        if (mn < MP) {
#pragma unroll
            for (int j = 0; j < 4; ++j) vn[j] = __builtin_nontemporal_load((gv4)(x + (size_t)mn * DM) + lane + 64 * j);
        }
        float sq = 0.f;
#pragma unroll
        for (int j = 0; j < 4; ++j) sq += (v[j].x * v[j].x + v[j].y * v[j].y) + (v[j].z * v[j].z + v[j].w * v[j].w);
        const float rstd = __builtin_amdgcn_rsqf(wave_sum(sq) * (1.f / DM) + EPS);
        __attribute__((address_space(1))) u32x2* o8 = (__attribute__((address_space(1))) u32x2*)(XN + (size_t)m * DM) + lane;
#pragma unroll
        for (int j = 0; j < 4; ++j) { u32x2 w; w.x = cvt_pk_bf16(v[j].x * rstd * gg[j].x, v[j].y * rstd * gg[j].y); w.y = cvt_pk_bf16(v[j].z * rstd * gg[j].z, v[j].w * rstd * gg[j].w); o8[64 * j] = w; }
    }
}
__device__ __forceinline__ void cache_convert(const float* ck, const float* cv, bf16_t* KS, bf16_t* VS, int W, int H, int NBS, int gtid, int gthreads) {
    const int nchunk = SBATCH * H * (W / 32) * 256;
    for (int id = gtid; id < 2 * nchunk; id += gthreads) {
        const bool isv = id >= nchunk; int c = isv ? id - nchunk : id;
        const int within = c & 255; c >>= 8; const int blk = c % (W / 32); c /= (W / 32); const int h = c % H, b = c / H;
        u32x4 w;
        if (!isv) { const int key = within & 31, hi = (within >> 5) & 1, d0 = within >> 6;
            const float* src = ck + ((size_t)(b * W + blk * 32 + key) * H + h) * 64 + 32 * hi + 8 * d0;
            const f32x4 a = *(const f32x4*)src, bb = *(const f32x4*)(src + 4);
            w.x = cvt_pk_bf16(a[0], a[1]); w.y = cvt_pk_bf16(a[2], a[3]); w.z = cvt_pk_bf16(bb[0], bb[1]); w.w = cvt_pk_bf16(bb[2], bb[3]);
            *(u32x4*)(KS + ((size_t)(b * H + h) * NBS + blk) * 2048 + within * 8) = w;
        } else { const int dl = within & 31, hi = (within >> 5) & 1, dblk = (within >> 6) & 1, s = within >> 7;
            float f[8];
#pragma unroll
            for (int j = 0; j < 8; ++j) { const int key = 16 * s + 4 * hi + (j & 3) + 8 * (j >> 2); f[j] = cv[((size_t)(b * W + blk * 32 + key) * H + h) * 64 + 32 * dblk + dl]; }
            w.x = cvt_pk_bf16(f[0], f[1]); w.y = cvt_pk_bf16(f[2], f[3]); w.z = cvt_pk_bf16(f[4], f[5]); w.w = cvt_pk_bf16(f[6], f[7]);
            *(u32x4*)(VS + ((size_t)(b * H + h) * NBS + blk) * 2048 + within * 8) = w;
        }
    }
}
struct TItem { const float* src; bf16_t* dst; int K; int Nsrc; };
__device__ __forceinline__ void t_load(f32x4 (&v)[8], const TItem& t, int lane) {
    const float* p = t.src + (size_t)(lane >> 3) * t.Nsrc + 4 * (lane & 7);
#pragma unroll
    for (int i = 0; i < 8; ++i) v[i] = __builtin_nontemporal_load((const __attribute__((address_space(1))) f32x4*)(p + (size_t)(8 * i) * t.Nsrc));
}
__device__ __forceinline__ void t_store(const f32x4 (&v)[8], const TItem& t, LAS float* scr, int lane) {
    const int c = lane & 7, r = lane >> 3;
#pragma unroll
    for (int i = 0; i < 8; ++i)
#pragma unroll
        for (int e = 0; e < 4; ++e) scr[(4 * c + e) * 65 + r + 8 * i] = v[i][e];
    asm volatile("s_waitcnt lgkmcnt(0)" ::: "memory");
#pragma unroll
    for (int j = 0; j < 4; ++j) { const int n = r + 8 * j; const LAS float* sp = scr + n * 65 + 8 * c;
        u32x4 o; o.x = cvt_pk_bf16(sp[0], sp[1]); o.y = cvt_pk_bf16(sp[2], sp[3]); o.z = cvt_pk_bf16(sp[4], sp[5]); o.w = cvt_pk_bf16(sp[6], sp[7]);
        *(__attribute__((address_space(1))) u32x4*)(t.dst + (size_t)n * t.K + 8 * c) = o; }
    asm volatile("s_waitcnt lgkmcnt(0)" ::: "memory");
}
__device__ __forceinline__ TItem t_decode(const Params& P, unsigned char* ws, int l, int pair, int it) {
    constexpr int I_IN = 16 * (NIN / 32), I_UP = 16 * (NUP / 32);
    TItem t;
    if (pair == 0) {
        if (it < I_IN) { const int nb = it % (NIN / 32), kb = it / (NIN / 32); t.K = DM; t.Nsrc = NIN; t.src = P.in[8] + (size_t)l * DM * NIN + (size_t)(64 * kb) * NIN + 32 * win_srcblk(nb); t.dst = (bf16_t*)(ws + WS_WIN) + (size_t)(32 * nb) * DM + 64 * kb; }
        else { const int r = it - I_IN, nb = r % 32, kb = r / 32; t.K = DM; t.Nsrc = DM; t.src = P.in[16] + (size_t)l * DM * DM + (size_t)(64 * kb) * DM + 32 * nb; t.dst = (bf16_t*)(ws + WS_WOUT) + (size_t)(32 * nb) * DM + 64 * kb; }
    } else {
        if (it < I_UP) { const int nb = it % (NUP / 32), kb = it / (NUP / 32); t.K = DM; t.Nsrc = NUP; t.src = P.in[18] + (size_t)l * DM * NUP + (size_t)(64 * kb) * NUP + 32 * wup_srcblk(nb); t.dst = (bf16_t*)(ws + WS_WUP) + (size_t)(32 * nb) * DM + 64 * kb; }
        else { const int r = it - I_UP, nb = r % 32, kb = r / 32; t.K = DFF; t.Nsrc = DM; t.src = P.in[21] + (size_t)l * DFF * DM + (size_t)(64 * kb) * DM + 32 * nb; t.dst = (bf16_t*)(ws + WS_WDN) + (size_t)(32 * nb) * DFF + 64 * kb; }
    }
    return t;
}
__device__ __forceinline__ void weight_items(const Params& P, int l, int pair, LAS unsigned char* lds, int widx, int nw, int wave_s, int lo_pm = 0, int hi_pm = 1000) {
    int tid_ = phase_tid(wave_s);
    const int lane = tid_ & 63, wave = tid_ >> 6;
    LAS float* scr = (LAS float*)(lds + wave * 16384);
    unsigned char* ws = P.ws; asm volatile("" : "+s"(ws));
    constexpr int I_IN = 16 * (NIN / 32), I_OUT = 16 * (DM / 32), I_UP = 16 * (NUP / 32), I_DN = (DFF / 64) * (DM / 32);
    const int NT = pair == 0 ? I_IN + I_OUT : I_UP + I_DN;
    const int N = (int)((long)NT * hi_pm / 1000);
    int it = (int)((long)NT * lo_pm / 1000) + widx; if (it >= N) return;
    f32x4 va[8], vb[8], vc[8];
    TItem ta = t_decode(P, ws, l, pair, it), tb = ta, tc = ta;
    t_load(va, ta, lane);
    if (it + nw < N) { tb = t_decode(P, ws, l, pair, it + nw); t_load(vb, tb, lane); }
    for (;;) {
        if (it + 2 * nw < N) { tc = t_decode(P, ws, l, pair, it + 2 * nw); t_load(vc, tc, lane); }
        t_store(va, ta, scr, lane);
        if (it + nw >= N) break;
        if (it + 3 * nw < N) { ta = t_decode(P, ws, l, pair, it + 3 * nw); t_load(va, ta, lane); }
        t_store(vb, tb, scr, lane);
        if (it + 2 * nw >= N) break;
        if (it + 4 * nw < N) { tb = t_decode(P, ws, l, pair, it + 4 * nw); t_load(vb, tb, lane); }
        t_store(vc, tc, scr, lane);
        if (it + 3 * nw >= N) break;
        it += 3 * nw;
    }
}
__device__ __forceinline__ void pre_phase(const Params& P, int l, LAS unsigned char* lds, int vcu, int G, const float* xp, const float* xs, int wave_s) {
    int tid_ = phase_tid(wave_s);
    const int tid = tid_, lane = tid & 63, wave = tid >> 6;
    const int gw = vcu * 8 + wave, NGW = G * 8;
    unsigned char* ws = P.ws; asm volatile("" : "+s"(ws));
    if (l == 0) weight_items(P, 0, 0, lds, gw, NGW, wave_s);
    else weight_items(P, l, 0, lds, gw, NGW, wave_s, 550, 1000);
    const int gtid = vcu * 512 + tid, gthreads = G * 512;
    cache_convert(P.in[2] + (size_t)l * SBATCH * 128 * 4 * 64, P.in[3] + (size_t)l * SBATCH * 128 * 4 * 64, (bf16_t*)(ws + WS_KAS), (bf16_t*)(ws + WS_VAS), 128, 4, NBS_A, gtid, gthreads);
    cache_convert(P.in[4] + (size_t)l * SBATCH * 512 * 16 * 64, P.in[5] + (size_t)l * SBATCH * 512 * 16 * 64, (bf16_t*)(ws + WS_KBS), (bf16_t*)(ws + WS_VBS), 512, 16, NBS_B, gtid, gthreads);
    if (l == 0) { const f32x4* src = (const f32x4*)xs; f32x4* dst = (f32x4*)(P.out + (size_t)MP * DM);
        for (int i = gtid; i < MS * DM / 4; i += gthreads) dst[i] = src[i]; }
    const float* g1 = P.in[7] + (size_t)l * DM; bf16_t* XN = (bf16_t*)(ws + WS_XN);
    norm_rows(xp, g1, XN, gw, NGW, lane);
    for (int m = MP + gw; m < MT; m += NGW) {
        if (l == 0) norm_row(xs + (size_t)(m - MP) * DM, g1, XN + (size_t)m * DM, lane);
        else { float* yr = P.out + (size_t)m * DM; norm_row(yr, g1, XN + (size_t)m * DM, lane, (const float*)(ws + WS_PART) + (size_t)(m - MP) * DM, 11, yr); }
    }
}
__device__ __forceinline__ void norm2_phase(const Params& P, int l, int vcu, int G, int wave_s) {
    int tid_ = phase_tid(wave_s);
    const int tid = tid_, lane = tid & 63, wave = tid >> 6; const int gw = vcu * 8 + wave, NGW = G * 8;
    unsigned char* ws = P.ws; const float* x = P.out; asm volatile("" : "+s"(ws), "+s"(x));
    const float* g2 = P.in[17] + (size_t)l * DM; bf16_t* XN = (bf16_t*)(ws + WS_XN);
    norm_rows(x, g2, XN, gw, NGW, lane);
    for (int m = MP + gw; m < MT; m += NGW) {
        { float* yr = P.out + (size_t)m * DM; norm_row(yr, g2, XN + (size_t)m * DM, lane, (const float*)(ws + WS_PART) + (size_t)(m - MP) * DM, 8, yr); }
    }
}
__device__ __forceinline__ void fix_phase(const Params& P, int l, int vcu, int G, int wave_s) {
    int tid_ = phase_tid(wave_s);
    const int gtid = vcu * 512 + tid_, gthreads = G * 512;
    unsigned char* ws = P.ws; asm volatile("" : "+s"(ws));
    const float* cw = P.in[19] + (size_t)l * 3 * NUP; const float* cb = P.in[20] + (size_t)l * NUP;
    const float* HU = (const float*)(ws + WS_HU); const float* US = (const float*)(ws + WS_US); bf16_t* ACT = (bf16_t*)(ws + WS_ACT);
    const float* cprev = P.in[6] + (size_t)l * SBATCH * 2 * NUP;
    float* o_sfc = P.out + O_SFC + (size_t)l * SBATCH * 2 * NUP;
    constexpr int DF4 = DFF / 4, NPF = 256 * 2 * DF4, NSF = 256 * DF4, NSC = SBATCH * 2 * NUP / 4;
    for (int id = gtid; id < NPF + NSF + NSC; id += gthreads) {
        if (id < NPF) {
            const int j = (id % DF4) * 4, rr = (id / DF4) & 1, seg = id / (2 * DF4);
            f32x4 c2[2];
#pragma unroll
            for (int bj = 0; bj < 2; ++bj) { const int col = bj * DFF + j;
                const float* h = HU + (size_t)seg * 4 * NUP + col; const float* hp = HU + (size_t)(seg - 1) * 4 * NUP + col;
                const bool first = (seg & 63) == 0; const f32x4 z = {0.f, 0.f, 0.f, 0.f};
                const f32x4 p62 = first ? z : *(const f32x4*)(hp + 2 * NUP), p63 = first ? z : *(const f32x4*)(hp + 3 * NUP), x0 = *(const f32x4*)h, x1 = *(const f32x4*)(h + NUP);
                const f32x4 w0 = *(const f32x4*)(cw + col), w1 = *(const f32x4*)(cw + NUP + col), w2 = *(const f32x4*)(cw + 2 * NUP + col), bb = *(const f32x4*)(cb + col);
                c2[bj] = rr == 0 ? bb + w0 * p62 + w1 * p63 + w2 * x0 : bb + w0 * p63 + w1 * x0 + w2 * x1; }
            u32x2 w; w.x = cvt_pk_bf16(gelu1(c2[0][0]) * c2[1][0], gelu1(c2[0][1]) * c2[1][1]); w.y = cvt_pk_bf16(gelu1(c2[0][2]) * c2[1][2], gelu1(c2[0][3]) * c2[1][3]);
            *(u32x2*)(ACT + (size_t)(seg * 64 + rr) * DFF + j) = w;
        } else if (id < NPF + NSF) {
            const int r = id - NPF; const int j = (r % DF4) * 4, row = r / DF4, b = row >> 5, t = row & 31;
            f32x4 c2[2];
#pragma unroll
            for (int bj = 0; bj < 2; ++bj) { const int col = bj * DFF + j;
                const f32x4 xm2 = *(const f32x4*)(t >= 2 ? US + (size_t)(row - 2) * NUP + col : cprev + (size_t)(b * 2 + t) * NUP + col);
                const f32x4 xm1 = *(const f32x4*)(t >= 1 ? US + (size_t)(row - 1) * NUP + col : cprev + (size_t)(b * 2 + 1) * NUP + col);
                const f32x4 x0 = *(const f32x4*)(US + (size_t)row * NUP + col);
                c2[bj] = *(const f32x4*)(cb + col) + *(const f32x4*)(cw + col) * xm2 + *(const f32x4*)(cw + NUP + col) * xm1 + *(const f32x4*)(cw + 2 * NUP + col) * x0; }
            u32x2 w; w.x = cvt_pk_bf16(gelu1(c2[0][0]) * c2[1][0], gelu1(c2[0][1]) * c2[1][1]); w.y = cvt_pk_bf16(gelu1(c2[0][2]) * c2[1][2], gelu1(c2[0][3]) * c2[1][3]);
            *(u32x2*)(ACT + (size_t)(MP + row) * DFF + j) = w;
        } else {
            const int r = (id - NPF - NSF) * 4; const int col = r % NUP, k = (r / NUP) & 1, b = r / (2 * NUP);
            *(f32x4*)(o_sfc + r) = *(const f32x4*)(US + (size_t)(b * 32 + 30 + k) * NUP + col);
        }
    }
}

template <int NQB, bool MIXB>
__device__ __forceinline__ void attn_item(bf16_t* Qp, const bf16_t* Kb, const bf16_t* Vb, int kb0, int kb1, int qpos0, float slope_l2, float sink_l2, const LAS float* tbl, int lane) {
    typedef const __attribute__((address_space(1))) bf16x8* gfrag;
    const int r32 = lane & 31, hi = lane >> 5;
    bf16x8 qf[NQB][4];
#pragma unroll
    for (int qb = 0; qb < NQB; ++qb)
#pragma unroll
        for (int d0 = 0; d0 < 4; ++d0) qf[qb][d0] = *(gfrag)(Qp + (size_t)(32 * qb + r32) * DM + 32 * hi + 8 * d0);
    f32x16 o[NQB][2]; float mrun[NQB], lrun[NQB];
#pragma unroll
    for (int qb = 0; qb < NQB; ++qb) { mrun[qb] = -1e30f; lrun[qb] = 0.f;
#pragma unroll
        for (int d = 0; d < 2; ++d)
#pragma unroll
            for (int r = 0; r < 16; ++r) o[qb][d][r] = 0.f; }
    const float SC = 0.125f * LOG2E;
    const float cfar = MIXB ? tbl[256] : 0.f;
    const bf16_t* kp = Kb + (size_t)kb0 * 2048 + hi * 256 + r32 * 8;
    const bf16_t* vp = Vb + (size_t)kb0 * 2048 + hi * 256 + r32 * 8;
    bf16x8 kf[4], vf[4];
    f32x16 sc[NQB], sn[NQB];
#pragma unroll
    for (int i = 0; i < 4; ++i) kf[i] = *(gfrag)(kp + i * 512);
#pragma unroll
    for (int qb = 0; qb < NQB; ++qb) {
#pragma unroll
        for (int r = 0; r < 16; ++r) sc[qb][r] = 0.f;
#pragma unroll
        for (int d0 = 0; d0 < 4; ++d0) sc[qb] = __builtin_amdgcn_mfma_f32_32x32x16_bf16(kf[d0], qf[qb][d0], sc[qb], 0, 0, 0);
    }
    kp += 2048;
    if (kb0 + 1 < kb1) {
#pragma unroll
        for (int i = 0; i < 4; ++i) kf[i] = *(gfrag)(kp + i * 512);
    }
    for (int kb = kb0; kb < kb1; ++kb) {
#pragma unroll
        for (int i = 0; i < 4; ++i) vf[i] = *(gfrag)(vp + i * 512);
        vp += 2048;
        if (kb + 1 < kb1) {
#pragma unroll
            for (int qb = 0; qb < NQB; ++qb) {
#pragma unroll
                for (int r = 0; r < 16; ++r) sn[qb][r] = 0.f;
#pragma unroll
                for (int d0 = 0; d0 < 4; ++d0) sn[qb] = __builtin_amdgcn_mfma_f32_32x32x16_bf16(kf[d0], qf[qb][d0], sn[qb], 0, 0, 0);
            }
            kp += 2048;
            if (kb + 2 < kb1) {
#pragma unroll
                for (int i = 0; i < 4; ++i) kf[i] = *(gfrag)(kp + i * 512);
            }
        }
        const bool far = MIXB && (qpos0 - (kb * 32 + 31) >= 128);
#pragma unroll
        for (int qb = 0; qb < NQB; ++qb) {
            f32x16 s = sc[qb];
            const int dbase = qpos0 + 32 * qb + r32 - kb * 32 - 4 * hi;
            float mx = -1e30f;
            if (far) {
#pragma unroll
                for (int r = 0; r < 16; ++r) { float t = __builtin_fmaf(s[r], SC, cfar); asm("" : "+v"(t)); s[r] = t; mx = __builtin_fmaxf(mx, t); }
            } else {
#pragma unroll
                for (int r = 0; r < 16; ++r) {
                    const int dist = dbase - ((r & 3) + 8 * (r >> 2));
                    float bias;
                    if (MIXB) { int idx = dist < -128 ? -128 : dist; idx = idx > 128 ? 128 : idx; bias = tbl[idx + 128]; }
                    else bias = -slope_l2 * __builtin_fabsf((float)dist);
                    float t = __builtin_fmaf(s[r], SC, bias); asm("" : "+v"(t)); s[r] = t; mx = __builtin_fmaxf(mx, t);
                }
            }
            mx = __builtin_fmaxf(mx, __shfl_xor(mx, 32));
            const float mold = mrun[qb];
            const bool grow = __builtin_amdgcn_ballot_w64(mx > mold + 6.0f) != 0;
            const float mnew = grow ? __builtin_fmaxf(mold, mx) : mold;
            mrun[qb] = mnew;
            float ls = 0.f;
#pragma unroll
            for (int r = 0; r < 16; ++r) { s[r] = __builtin_amdgcn_exp2f(s[r] - mnew); ls += s[r]; }
            if (grow) {
                const float alpha = __builtin_amdgcn_exp2f(mold - mnew);
                lrun[qb] *= alpha;
#pragma unroll
                for (int d = 0; d < 2; ++d)
#pragma unroll
                    for (int r = 0; r < 16; ++r) o[qb][d][r] *= alpha;
            }
            lrun[qb] += ls;
            u32x4 p0, p1;
            p0.x = cvt_pk_bf16(s[0], s[1]); p0.y = cvt_pk_bf16(s[2], s[3]); p0.z = cvt_pk_bf16(s[4], s[5]); p0.w = cvt_pk_bf16(s[6], s[7]);
            p1.x = cvt_pk_bf16(s[8], s[9]); p1.y = cvt_pk_bf16(s[10], s[11]); p1.z = cvt_pk_bf16(s[12], s[13]); p1.w = cvt_pk_bf16(s[14], s[15]);
            const bf16x8 pf0 = __builtin_bit_cast(bf16x8, p0), pf1 = __builtin_bit_cast(bf16x8, p1);
            o[qb][0] = __builtin_amdgcn_mfma_f32_32x32x16_bf16(vf[0], pf0, o[qb][0], 0, 0, 0);
            o[qb][1] = __builtin_amdgcn_mfma_f32_32x32x16_bf16(vf[1], pf0, o[qb][1], 0, 0, 0);
            o[qb][0] = __builtin_amdgcn_mfma_f32_32x32x16_bf16(vf[2], pf1, o[qb][0], 0, 0, 0);
            o[qb][1] = __builtin_amdgcn_mfma_f32_32x32x16_bf16(vf[3], pf1, o[qb][1], 0, 0, 0);
        }
#pragma unroll
        for (int qb = 0; qb < NQB; ++qb) sc[qb] = sn[qb];
    }
#pragma unroll
    for (int qb = 0; qb < NQB; ++qb) {
        float lt = lrun[qb] + __shfl_xor(lrun[qb], 32);
        if (!MIXB) lt += __builtin_amdgcn_exp2f(sink_l2 - mrun[qb]);
        const float inv = 1.0f / lt;
        bf16_t* op = Qp + (size_t)(32 * qb + r32) * DM + 4 * hi;
#pragma unroll
        for (int d = 0; d < 2; ++d)
#pragma unroll
            for (int g = 0; g < 4; ++g) { u32x2 w; w.x = cvt_pk_bf16(o[qb][d][4 * g] * inv, o[qb][d][4 * g + 1] * inv); w.y = cvt_pk_bf16(o[qb][d][4 * g + 2] * inv, o[qb][d][4 * g + 3] * inv);
                *(__attribute__((address_space(1))) u32x2*)(op + 32 * d + 8 * g) = w; }
    }
}
__device__ __forceinline__ void attn_phase(const Params& P, int l, LAS unsigned char* lds, int vcu, int G, int wave_s) {
    int tid_ = phase_tid(wave_s);
    const int tid = tid_, lane = tid & 63, wave = __builtin_amdgcn_readfirstlane(tid >> 6);
    LAS float* tbl = (LAS float*)(lds + wave * 2048);
    unsigned char* ws = P.ws; asm volatile("" : "+s"(ws));
    bf16_t* QA = (bf16_t*)(ws + WS_QA); bf16_t* QB = (bf16_t*)(ws + WS_QB);
    const float* sinks = P.in[14] + l * 16; const float* rel = P.in[15] + (size_t)l * 257 * 16;
    const int gw = vcu * 8 + wave, NGW = G * 8;
    int cur_h = -1;
    for (int id = gw; id < NBATCH * 16 * 64; id += NGW) {
        const int c = id & 63, h = (id >> 6) & 15, b = id >> 10;
        if (h != cur_h) { for (int i = lane; i < 257; i += 64) tbl[i] = rel[i * 16 + h] * LOG2E; cur_h = h; asm volatile("s_waitcnt lgkmcnt(0)" ::: "memory"); }
        const int kb0 = c >= 8 ? 2 * (c - 8) : 0;
        attn_item<2, true>(QB + ((size_t)b * SEQ + c * 64) * DM + h * 64, (const bf16_t*)(ws + WS_KB) + (size_t)(b * 16 + h) * NT32 * 2048, (const bf16_t*)(ws + WS_VB) + (size_t)(b * 16 + h) * NT32 * 2048,
                           kb0, 2 * (c + 1), 64 * c, 0.f, 0.f, tbl, lane);
    }
    for (int id = gw; id < NBATCH * 16 * 64; id += NGW) {
        const int c = id & 63, h = (id >> 6) & 15, b = id >> 10;
        const int kb0 = c >= 2 ? 2 * (c - 2) : 0;
        const float slope = __builtin_amdgcn_exp2f(-0.5f * (float)(h + 1)) * LOG2E;
        attn_item<2, false>(QA + ((size_t)b * SEQ + c * 64) * DM + h * 64, (const bf16_t*)(ws + WS_KA) + (size_t)(b * 4 + (h >> 2)) * NT32 * 2048, (const bf16_t*)(ws + WS_VA) + (size_t)(b * 4 + (h >> 2)) * NT32 * 2048,
                            kb0, 2 * (c + 1), 64 * c, slope, sinks[h] * LOG2E, tbl, lane);
    }
    if (NGW == 2048 && (gw & 63) < 8) {
        const int cs = gw & 63, j = gw >> 6, idx = (cs & 3) * 32 + j, h = idx & 15, b = idx >> 4;
        if (cs < 4) {
            if (h != cur_h) { for (int i = lane; i < 257; i += 64) tbl[i] = rel[i * 16 + h] * LOG2E; cur_h = h; asm volatile("s_waitcnt lgkmcnt(0)" ::: "memory"); }
            attn_item<1, true>(QB + ((size_t)MP + b * STOK) * DM + h * 64, (const bf16_t*)(ws + WS_KBS) + (size_t)(b * 16 + h) * NBS_B * 2048, (const bf16_t*)(ws + WS_VBS) + (size_t)(b * 16 + h) * NBS_B * 2048,
                               0, NBS_B, 512, 0.f, 0.f, tbl, lane);
        } else {
            const float slope = __builtin_amdgcn_exp2f(-0.5f * (float)(h + 1)) * LOG2E;
            attn_item<1, false>(QA + ((size_t)MP + b * STOK) * DM + h * 64, (const bf16_t*)(ws + WS_KAS) + (size_t)(b * 4 + (h >> 2)) * NBS_A * 2048, (const bf16_t*)(ws + WS_VAS) + (size_t)(b * 4 + (h >> 2)) * NBS_A * 2048,
                                0, NBS_A, 128, slope, sinks[h] * LOG2E, tbl, lane);
        }
    } else if (NGW != 2048 && wave == 0) for (int id = vcu; id < 2 * SBATCH * 16; id += G) {
        const int h = id & 15, b = (id >> 4) & 7, mxr = id >> 7;
        if (mxr) {
            if (h != cur_h) { for (int i = lane; i < 257; i += 64) tbl[i] = rel[i * 16 + h] * LOG2E; cur_h = h; asm volatile("s_waitcnt lgkmcnt(0)" ::: "memory"); }
            attn_item<1, true>(QB + ((size_t)MP + b * STOK) * DM + h * 64, (const bf16_t*)(ws + WS_KBS) + (size_t)(b * 16 + h) * NBS_B * 2048, (const bf16_t*)(ws + WS_VBS) + (size_t)(b * 16 + h) * NBS_B * 2048,
                               0, NBS_B, 512, 0.f, 0.f, tbl, lane);
        } else {
            const float slope = __builtin_amdgcn_exp2f(-0.5f * (float)(h + 1)) * LOG2E;
            attn_item<1, false>(QA + ((size_t)MP + b * STOK) * DM + h * 64, (const bf16_t*)(ws + WS_KAS) + (size_t)(b * 4 + (h >> 2)) * NBS_A * 2048, (const bf16_t*)(ws + WS_VAS) + (size_t)(b * 4 + (h >> 2)) * NBS_A * 2048,
                                0, NBS_A, 128, slope, sinks[h] * LOG2E, tbl, lane);
        }
    }
}

#define XB_TMO      128
#define XB_XCNT(j)  (256  + 64 * (j))
#define XB_XSUB(j)  (1280 + 64 * (j))
#define XB_XGEN(j)  (2304 + 64 * (j))
#define XB_TOP      3328
#define XB_TOPGEN   3392
#define XCD_BAR_WORDS 3456
#define XB_SPIN_CAP (1u << 20)
__device__ __forceinline__ unsigned xb_ld(unsigned* p)              { return __hip_atomic_load(p, __ATOMIC_RELAXED, __HIP_MEMORY_SCOPE_AGENT); }
__device__ __forceinline__ unsigned xb_add(unsigned* p, unsigned v) { return __hip_atomic_fetch_add(p, v, __ATOMIC_RELAXED, __HIP_MEMORY_SCOPE_AGENT); }
__device__ __forceinline__ unsigned xb_xcc_id() { return (unsigned)__builtin_amdgcn_s_getreg((3 << 11) | 20) & 0xFu; }
#define XB_SPIN(cond, bar) do { unsigned _sp = 0; while (cond) { __builtin_amdgcn_s_sleep(1); \
    if ((++_sp & 255u) == 0u) { if (xb_ld(&(bar)[XB_TMO])) break; if (_sp > XB_SPIN_CAP) { atomicAdd(&(bar)[XB_TMO], 1u); break; } } } } while (0)
struct XcdBarrier { unsigned* bar; unsigned x; volatile LAS unsigned* st; };
__device__ __forceinline__ void xcd_barrier_complete(unsigned* bar, unsigned x, unsigned& nloc, unsigned& nx) {
    const unsigned G = gridDim.x * gridDim.y * gridDim.z;
    unsigned sum, cnt, mine, sp = 0u;
    for (;;) {
        sum = 0u; cnt = 0u; mine = 0u;
#pragma unroll
        for (unsigned j = 0; j < 16; ++j) { const unsigned c = xb_ld(&bar[XB_XCNT(j)]); sum += c; cnt += (c > 0u) ? 1u : 0u; mine = (j == x) ? c : mine; }
        if (sum == G) break;
        __builtin_amdgcn_s_sleep(1);
        if ((++sp & 255u) == 0u) { if (xb_ld(&bar[XB_TMO])) break; if (sp > XB_SPIN_CAP) { atomicAdd(&bar[XB_TMO], 1u); break; } }
    }
    nloc = mine > 0u ? mine : 1u; nx = cnt > 0u ? cnt : 1u;
}
__device__ __forceinline__ void xcd_barrier(const XcdBarrier& b, int wave_s) {
    asm volatile("s_waitcnt vmcnt(0)" ::: "memory");
    __syncthreads();
    if (wave_s == 0) { int lane; asm volatile("v_mbcnt_lo_u32_b32 %0, -1, 0\n\tv_mbcnt_hi_u32_b32 %0, -1, %0" : "=v"(lane));
    if (lane == 0) {
        unsigned* bar = b.bar;
        __builtin_amdgcn_s_waitcnt(0);
        unsigned nloc = b.st[0], nx = b.st[1];
        if (nloc == 0u) { xcd_barrier_complete(bar, b.x, nloc, nx); b.st[0] = nloc; b.st[1] = nx; }
        const unsigned old = xb_add(&bar[XB_XSUB(b.x)], 1u);
        const unsigned gen = old / nloc;
        if (old + 1u == (gen + 1u) * nloc) {
            __builtin_amdgcn_fence(__ATOMIC_RELEASE, "agent");
            asm volatile("s_waitcnt vmcnt(0)" ::: "memory");
            const unsigned og = xb_add(&bar[XB_TOP], 1u);
            const unsigned tg = og / nx;
            if (og + 1u == (tg + 1u) * nx) xb_add(&bar[XB_TOPGEN], 1u);
            else XB_SPIN(xb_ld(&bar[XB_TOPGEN]) == tg, bar);
            __builtin_amdgcn_fence(__ATOMIC_ACQUIRE, "agent");
            xb_add(&bar[XB_XGEN(b.x)], 1u);
            asm volatile("s_waitcnt vmcnt(0)" ::: "memory");
        } else {
            XB_SPIN(xb_ld(&bar[XB_XGEN(b.x)]) == gen, bar);
            __builtin_amdgcn_fence(__ATOMIC_ACQUIRE, "agent");
            asm volatile("s_waitcnt vmcnt(0)" ::: "memory");
        }
    } }
    __syncthreads();
}
#ifndef PROBE_MASK
#define PROBE_MASK 0u
#endif
#define PH_BEGIN(BIT) unsigned long long _t0_##BIT = 0; if ((PROBE_MASK >> (BIT)) & 1u) _t0_##BIT = __builtin_amdgcn_s_memrealtime();
#define PH_END(BIT) if ((PROBE_MASK >> (BIT)) & 1u) { const unsigned long long _t1 = __builtin_amdgcn_s_memrealtime(); const unsigned long long _dt = _t1 - _t0_##BIT; while (__builtin_amdgcn_s_memrealtime() - _t1 < _dt) __builtin_amdgcn_s_sleep(8); }
constexpr int LDS_BYTES = 135168;
__global__ void __launch_bounds__(512, 2) fwd_megakernel(Params P) {
    extern __shared__ __attribute__((aligned(16))) unsigned char lds_raw[];
    LAS unsigned char* lds = (LAS unsigned char*)lds_raw;
    cg::grid_group grid = cg::this_grid();
    const int G = gridDim.x, bx = blockIdx.x;
    const int wave_s = __builtin_amdgcn_readfirstlane((int)threadIdx.x >> 6);
    const int vcu = (G % 8 == 0) ? (bx % 8) * (G / 8) + bx / 8 : bx;
    unsigned char* ws = P.ws;
    bf16_t* XN = (bf16_t*)(ws + WS_XN);
    volatile LAS unsigned* bst = (volatile LAS unsigned*)(lds + 131072 + 64);
    if (threadIdx.x < 2) bst[threadIdx.x] = 0u;
    __syncthreads();
    XcdBarrier bar; bar.bar = (unsigned*)ws + 1024; bar.x = xb_xcc_id(); bar.st = bst;
    if (threadIdx.x == 0) (void)xb_add(&bar.bar[XB_XCNT(bar.x)], 1u);
#define GRID_BAR() xcd_barrier(bar, wave_s)
    if (P.ws == nullptr) grid.sync();
    float* Y = P.out;

    for (int l = 0; l < DEPTH; ++l) {
        PH_BEGIN(0)
#ifndef X_NOPRE
        pre_phase(P, l, lds, vcu, G, l == 0 ? P.in[0] : Y, l == 0 ? P.in[1] : Y + (size_t)MP * DM, wave_s);
#endif
        PH_END(0)
        GRID_BAR();
        {
            PH_BEGIN(1)
            pg8::Gemm g{XN, (const bf16_t*)(ws + WS_WIN), MT, NIN, DM}; pg8::StaticOrder S; S.init(18, 26, 1, 16, G, bx);
            EpiG1a E{ws, P.out, P.in[10] + l * 64, P.in[11] + l * 64, P.in[12] + l * 64, P.in[13] + l * 64, P.in[9] + (size_t)l * 2 * DM, l};
#ifndef X_NOG1A
            pg8::gemm_phase<EpiG1a>(lds, g, S, E, wave_s);
#endif
            { const int rem = (64 * 18 + 26) % G, first = rem, nidle = rem ? G - rem : G;
              if (bx >= first) weight_items(P, l, 1, lds, (bx - first) * 8 + wave_s, nidle * 8, wave_s); }
            PH_END(1)
        }
        GRID_BAR();
        PH_BEGIN(2)
#ifndef X_NOATT
        attn_phase(P, l, lds, vcu, G, wave_s);
#endif
        PH_END(2)
        GRID_BAR();
        {
            PH_BEGIN(3)
            pg8::Gemm g{XN, (const bf16_t*)(ws + WS_WIN) + (size_t)NQKV * DM, MT, NIN - NQKV, DM}; pg8::StaticOrder S; S.init(8, 0, 1, 16, G, bx);
            EpiG1b E{(bf16_t*)(ws + WS_QA), (const bf16_t*)(ws + WS_QB), P.in[9] + (size_t)l * 2 * DM};
            {
                const int tidm = phase_tid(wave_s);
                for (int r = vcu; r < MS; r += G) {
                    bf16_t* oa = (bf16_t*)(ws + WS_QA) + (size_t)(MP + r) * DM + 2 * tidm; const bf16_t* ob = (const bf16_t*)(ws + WS_QB) + (size_t)(MP + r) * DM + 2 * tidm;
                    const bf16_t* gs = (const bf16_t*)(ws + WS_GS) + (size_t)r * 2048 + 2 * tidm;
                    const unsigned wa = *(const unsigned*)oa, wb = *(const unsigned*)ob, ga = *(const unsigned*)gs, gb = *(const unsigned*)(gs + DM);
                    const float m0 = bf2f((unsigned short)ga) * bf2f((unsigned short)wa) + bf2f((unsigned short)gb) * bf2f((unsigned short)wb);
                    const float m1 = bf2f((unsigned short)(ga >> 16)) * bf2f((unsigned short)(wa >> 16)) + bf2f((unsigned short)(gb >> 16)) * bf2f((unsigned short)(wb >> 16));
                    *(unsigned*)oa = cvt_pk_bf16(m0, m1);
                }
            }
#ifndef X_NOG1B
            pg8::gemm_phase<EpiG1b>(lds, g, S, E, wave_s);
#endif
            PH_END(3)
        }
        GRID_BAR();
        {
            PH_BEGIN(4)
            pg8::Gemm g{(const bf16_t*)(ws + WS_QA), (const bf16_t*)(ws + WS_WOUT), MT, DM, DM}; pg8::StaticOrder S; S.init(4, 4, 8, 16, G, bx);
            EpiRes E{l == 0 ? P.in[0] : Y, Y, (float*)(ws + WS_PART)};
            pg8::gemm_phase<EpiRes>(lds, g, S, E, wave_s);
            PH_END(4)
        }
        GRID_BAR();
        { PH_BEGIN(5)
        norm2_phase(P, l, vcu, G, wave_s);
        PH_END(5) }
        GRID_BAR();
        {
            PH_BEGIN(6)
            pg8::Gemm g{XN, (const bf16_t*)(ws + WS_WUP), MT, NUP, DM}; pg8::StaticOrder S; S.init(22, 22, 1, 16, G, bx);
            EpiG3 E{ws, P.out + O_PFC + (size_t)l * NBATCH * 2 * NUP, P.in[19] + (size_t)l * 3 * NUP, P.in[20] + (size_t)l * NUP};
#ifndef X_NOG3
            pg8::gemm_phase<EpiG3>(lds, g, S, E, wave_s);
#endif
            if (l + 1 < DEPTH) { const int rem = (64 * 22 + 22) % G, first = rem, nidle = rem ? G - rem : G;
              if (bx >= first) weight_items(P, l + 1, 0, lds, (bx - first) * 8 + wave_s, nidle * 8, wave_s, 0, 550); }
            PH_END(6)
        }
        GRID_BAR();
        { PH_BEGIN(7)
#ifndef X_NOFIX
        fix_phase(P, l, vcu, G, wave_s);
#endif
        PH_END(7) }
        GRID_BAR();
        {
            PH_BEGIN(8)
            pg8::Gemm g{(const bf16_t*)(ws + WS_ACT), (const bf16_t*)(ws + WS_WDN), MT, DM, DFF}; pg8::StaticOrder S; S.init(4, 4, 11, 44, G, bx);
                        EpiRes E{Y, Y, (float*)(ws + WS_PART)};
            pg8::gemm_phase<EpiRes>(lds, g, S, E, wave_s);
            PH_END(8)
        }
        GRID_BAR();
    }
    {
        const int tidt = phase_tid(wave_s), gtid = vcu * 512 + tidt;
        f32x4* ys = (f32x4*)(Y + (size_t)MP * DM); const f32x4* pp = (const f32x4*)(ws + WS_PART);
        for (int i = gtid; i < MS * DM / 4; i += G * 512) { f32x4 v = ys[i];
#pragma unroll
            for (int p = 0; p < 11; ++p) v += pp[(size_t)p * (MS * DM / 4) + i];
            ys[i] = v; }
    }
}

extern "C" void kernel_launch(void* const* d_in, const int* in_sizes, int n_in, void* d_out, int out_size, void* d_ws, size_t ws_size, hipStream_t stream) {
    static int grid_blocks = 0;
    if (grid_blocks == 0) {
        if (n_in != 22 || (size_t)out_size != O_END || ws_size < WS_END) { fprintf(stderr, "kernel_launch: unexpected shapes: n_in %d out %d ws %zu\n", n_in, out_size, ws_size); grid_blocks = -1; return; }
        int dev = 0, cus = 0, per_cu = 0;
        hipGetDevice(&dev); hipDeviceGetAttribute(&cus, hipDeviceAttributeMultiprocessorCount, dev);
        hipFuncSetAttribute((const void*)fwd_megakernel, hipFuncAttributeMaxDynamicSharedMemorySize, LDS_BYTES);
        hipOccupancyMaxActiveBlocksPerMultiprocessor(&per_cu, (const void*)fwd_megakernel, 512, LDS_BYTES);
        if (per_cu < 1) { fprintf(stderr, "kernel_launch: occupancy query says %d blocks/CU\n", per_cu); per_cu = 1; }
        (void)hipGetLastError();
        grid_blocks = cus;
    }
    if (grid_blocks < 0) return;
    (void)hipMemsetAsync(d_ws, 0, 65536, stream);
    Params p{};
    for (int i = 0; i < 22; ++i) p.in[i] = (const float*)d_in[i];
    p.out = (float*)d_out; p.ws = (unsigned char*)d_ws;
    void* args[] = {&p};
    hipError_t e = hipLaunchCooperativeKernel((const void*)fwd_megakernel, dim3(grid_blocks), dim3(512), args, LDS_BYTES, stream);
    if (e != hipSuccess) fprintf(stderr, "cooperative launch failed: %s (grid %d)\n", hipGetErrorString(e), grid_blocks);
}
```
